# Optimizing an MI355X kernel written in HIP

```python
import jax, jax.numpy as jnp
from jax import lax
import numpy as np

D_MODEL = 1024
BATCH = 2
SEQ = 8192
DEPTH = 1

GRID_W = 64
CTX_LEN = 256

HEAD_DIM = 64
N_HEADS = 16
N_KV_HEADS = 4
GROUP = N_HEADS // N_KV_HEADS
ATTN_W = N_HEADS * HEAD_DIM
KV_W = N_KV_HEADS * HEAD_DIM
WINDOW = 128
ATTN_BLOCK = 128
ATTN_SCALE = HEAD_DIM ** -0.5
ROPE_BASE = 10000.0
ROPE_PAIRS = HEAD_DIM // 4

POOL_WINDOWS = (2, 4, 8, 16)
N_POOL_GROUPS = len(POOL_WINDOWS)
POOL_W = D_MODEL
POOL_GROUP_W = POOL_W // N_POOL_GROUPS

IN_W = ATTN_W + 2 * KV_W + POOL_W + 2 * D_MODEL
SPLIT_POINTS = (ATTN_W, ATTN_W + KV_W, ATTN_W + 2 * KV_W,
                ATTN_W + 2 * KV_W + POOL_W, ATTN_W + 2 * KV_W + POOL_W + D_MODEL)

N_EXPERTS = 32
TOP_K = 4
D_FF = D_MODEL
SWIGLU_ALPHA = 1.702
SWIGLU_LIMIT = 7.0
EXPERT_BLOCK = 128

NORM_EPS = 1e-5
NEG_INF = -1e30

kernel_name = 'hybrid_dit_gqa_pool_moe_block'


def rmsnorm(x, g):
    xf = x.astype(jnp.float32)
    y = xf * lax.rsqrt(jnp.mean(xf * xf, axis=-1, keepdims=True) + NORM_EPS)
    return (y * g.astype(jnp.float32)).astype(x.dtype)


def modulate(h, shift, scale):
    return h * (1 + scale) + shift


def apply_axial_rope(t, cos, sin):
    B, L, H, _ = t.shape
    tr = t.reshape(B, L, H, 2, 2, ROPE_PAIRS)
    t1, t2 = tr[..., 0, :], tr[..., 1, :]
    cs = cos[None, :, None].astype(t.dtype)
    sn = sin[None, :, None].astype(t.dtype)
    out = jnp.stack([t1 * cs - t2 * sn, t2 * cs + t1 * sn], axis=-2)
    return out.reshape(t.shape)


def windowed_attention(q, k, v, k_ctx, v_ctx, sink):
    B, L = q.shape[:2]
    Lc = k_ctx.shape[1]
    nblk = L // ATTN_BLOCK
    qb = q.reshape(B, nblk, ATTN_BLOCK, N_KV_HEADS, GROUP, HEAD_DIM).transpose(1, 0, 2, 3, 4, 5)
    pad = ((0, 0), (ATTN_BLOCK, ATTN_BLOCK), (0, 0), (0, 0))

    def band(t):
        tp = jnp.pad(t, pad).reshape(B, nblk + 2, ATTN_BLOCK, N_KV_HEADS, HEAD_DIM)
        tb = jnp.concatenate([tp[:, :-2], tp[:, 1:-1], tp[:, 2:]], axis=2)
        return tb.transpose(1, 0, 2, 3, 4)

    k_band, v_band = band(k), band(v)
    sink_l = sink.reshape(N_KV_HEADS, GROUP).astype(jnp.float32)
    q_off = jnp.arange(ATTN_BLOCK, dtype=jnp.int32)
    k_off = jnp.arange(3 * ATTN_BLOCK, dtype=jnp.int32) - ATTN_BLOCK
    n_loc = 3 * ATTN_BLOCK

    def one_block(args):
        qn, kn, vn, n = args
        s_loc = jnp.einsum('bqhgd,bshd->bhgqs', qn, kn).astype(jnp.float32) * ATTN_SCALE
        s_ctx = jnp.einsum('bqhgd,bchd->bhgqc', qn, k_ctx).astype(jnp.float32) * ATTN_SCALE
        qpos = n * ATTN_BLOCK + q_off
        kpos = n * ATTN_BLOCK + k_off
        valid = ((jnp.abs(qpos[:, None] - kpos[None, :]) <= WINDOW)
                 & (kpos[None, :] >= 0) & (kpos[None, :] < L))
        s_loc = jnp.where(valid, s_loc, NEG_INF)
        sink_b = jnp.broadcast_to(sink_l[None, :, :, None, None], s_loc.shape[:-1] + (1,))
        probs = jax.nn.softmax(jnp.concatenate([s_loc, s_ctx, sink_b], axis=-1), axis=-1)
        p_loc = probs[..., :n_loc].astype(vn.dtype)
        p_ctx = probs[..., n_loc:n_loc + Lc].astype(v_ctx.dtype)
        return (jnp.einsum('bhgqs,bshd->bqhgd', p_loc, vn)
                + jnp.einsum('bhgqc,bchd->bqhgd', p_ctx, v_ctx))

    out = lax.map(one_block, (qb, k_band, v_band, jnp.arange(nblk, dtype=jnp.int32)))
    return out.transpose(1, 0, 2, 3, 4, 5).reshape(B, L, ATTN_W)


def context_attention(q, k, v, sink):
    B, Lc = q.shape[:2]
    qg = q.reshape(B, Lc, N_KV_HEADS, GROUP, HEAD_DIM)
    s = jnp.einsum('bqhgd,bchd->bhgqc', qg, k).astype(jnp.float32) * ATTN_SCALE
    sink_b = jnp.broadcast_to(
        sink.reshape(N_KV_HEADS, GROUP).astype(jnp.float32)[None, :, :, None, None],
        s.shape[:-1] + (1,))
    p = jax.nn.softmax(jnp.concatenate([s, sink_b], axis=-1), axis=-1)[..., :Lc].astype(v.dtype)
    return jnp.einsum('bhgqc,bchd->bqhgd', p, v).reshape(B, Lc, ATTN_W)


def multiscale_pool(u, w_pool, pool_scale):
    B, L, _ = u.shape
    ug = u.reshape(B, L, N_POOL_GROUPS, POOL_GROUP_W).astype(jnp.float32)
    cs = jnp.concatenate([jnp.zeros_like(ug[:, :1]), jnp.cumsum(ug, axis=1)], axis=1)
    half = jnp.array([w // 2 for w in POOL_WINDOWS], dtype=jnp.int32)
    t = jnp.arange(L, dtype=jnp.int32)[:, None]
    lo = jnp.clip(t - half[None, :], 0, L)
    hi = jnp.clip(t + half[None, :], 0, L)
    g = jnp.arange(N_POOL_GROUPS, dtype=jnp.int32)[None, :]
    window_sum = cs[:, hi, g] - cs[:, lo, g]
    mean = window_sum / (hi - lo).astype(jnp.float32)[None, :, :, None]
    diff = (mean - ug).astype(u.dtype)
    mixed = jnp.einsum('blgc,gcd->blgd', diff, w_pool)
    return mixed.reshape(B, L, POOL_W) * pool_scale


def merge_branches(attn_o, pool_o, g_attn, g_pool, w_attn_br, w_pool_br, w_out):
    merged = (jax.nn.sigmoid(g_attn) * (attn_o @ w_attn_br)
              + jax.nn.sigmoid(g_pool) * (pool_o @ w_pool_br))
    return merged @ w_out


def clamped_swiglu(gu):
    gate = jnp.minimum(gu[..., :D_FF], SWIGLU_LIMIT)
    lin = jnp.clip(gu[..., D_FF:], -SWIGLU_LIMIT, SWIGLU_LIMIT)
    return gate * jax.nn.sigmoid(SWIGLU_ALPHA * gate) * (lin + 1)


def moe_ffn(h, w_router, b_router, w_gu, b_gu, w_down, b_down):
    N, D = h.shape
    logits = (h @ w_router + b_router).astype(jnp.float32)
    top_val, top_idx = lax.top_k(logits, TOP_K)
    gate_w = jax.nn.softmax(top_val, axis=-1).astype(h.dtype)
    NK = N * TOP_K
    flat_e = top_idx.reshape(-1)
    order = jnp.argsort(flat_e)
    sorted_e = flat_e[order]
    tok_sorted = (order // TOP_K).astype(jnp.int32)
    counts = jnp.zeros((N_EXPERTS,), jnp.int32).at[flat_e].add(1)
    padded = (counts + EXPERT_BLOCK - 1) // EXPERT_BLOCK * EXPERT_BLOCK
    start = jnp.cumsum(counts) - counts
    pend = jnp.cumsum(padded)
    pstart = pend - padded
    dest = pstart[sorted_e] + (jnp.arange(NK, dtype=jnp.int32) - start[sorted_e])
    num_blocks = -(-NK // EXPERT_BLOCK) + N_EXPERTS
    P = num_blocks * EXPERT_BLOCK
    tok_buf = jnp.full((P,), N, jnp.int32).at[dest].set(tok_sorted)
    h_pad = jnp.concatenate([h, jnp.zeros((1, D), h.dtype)], axis=0)
    x_blocks = h_pad[tok_buf].reshape(num_blocks, EXPERT_BLOCK, D)
    block_start = jnp.arange(num_blocks, dtype=jnp.int32) * EXPERT_BLOCK
    block_e = jnp.minimum(jnp.searchsorted(pend, block_start, side='right'), N_EXPERTS - 1)

    def expert_block(args):
        xb, e = args
        gu = xb @ w_gu[e] + b_gu[e]
        return clamped_swiglu(gu) @ w_down[e] + b_down[e]

    y_buf = lax.map(expert_block, (x_blocks, block_e)).reshape(P, D)
    y_sorted = y_buf[dest] * gate_w.reshape(-1)[order][:, None]
    return jax.ops.segment_sum(y_sorted, tok_sorted, num_segments=N)


def hybrid_layer(x, ctx, rope_cos, rope_sin, c, c_ctx, w_ada, b_ada, norm1_g, norm2_g,
                 w_in, b_in, attn_sink, w_pool, pool_scale, w_attn_br, w_pool_br, w_out,
                 w_router, b_router, w_gu, b_gu, w_down, b_down, update_ctx):
    B, L, D = x.shape
    Lc = ctx.shape[1]
    mod_x = (jax.nn.silu(c) @ w_ada + b_ada)[:, None, :]
    mod_c = jax.nn.silu(c_ctx) @ w_ada + b_ada
    sh1x, sc1x, g1x, sh2x, sc2x, g2x = jnp.split(mod_x, 6, axis=-1)
    sh1c, sc1c, g1c, sh2c, sc2c, g2c = jnp.split(mod_c, 6, axis=-1)

    hx = modulate(rmsnorm(x, norm1_g), sh1x, sc1x)
    hc = modulate(rmsnorm(ctx, norm1_g), sh1c, sc1c)
    qx, kx, vx, ux, gax, gpx = jnp.split(hx @ w_in + b_in, SPLIT_POINTS, axis=-1)
    kv_sl = slice(ATTN_W, ATTN_W + 2 * KV_W)
    kc, vc = jnp.split(hc @ w_in[:, kv_sl] + b_in[kv_sl], 2, axis=-1)
    kc = kc.reshape(B, Lc, N_KV_HEADS, HEAD_DIM)
    vc = vc.reshape(B, Lc, N_KV_HEADS, HEAD_DIM)
    qx = apply_axial_rope(qx.reshape(B, L, N_HEADS, HEAD_DIM), rope_cos, rope_sin)
    kx = apply_axial_rope(kx.reshape(B, L, N_KV_HEADS, HEAD_DIM), rope_cos, rope_sin)
    vx = vx.reshape(B, L, N_KV_HEADS, HEAD_DIM)
    attn_x = windowed_attention(qx, kx, vx, kc, vc, attn_sink)
    pool_x = multiscale_pool(ux, w_pool, pool_scale)
    x = x + g1x * merge_branches(attn_x, pool_x, gax, gpx, w_attn_br, w_pool_br, w_out)
    if update_ctx:
        qc, _, _, uc, gac, gpc = jnp.split(hc @ w_in + b_in, SPLIT_POINTS, axis=-1)
        attn_c = context_attention(qc.reshape(B, Lc, N_HEADS, HEAD_DIM), kc, vc, attn_sink)
        pool_c = multiscale_pool(uc, w_pool, pool_scale)
        ctx = ctx + g1c * merge_branches(attn_c, pool_c, gac, gpc, w_attn_br, w_pool_br, w_out)

    h2x = modulate(rmsnorm(x, norm2_g), sh2x, sc2x).reshape(B * L, D)
    if update_ctx:
        h2c = modulate(rmsnorm(ctx, norm2_g), sh2c, sc2c).reshape(B * Lc, D)
        y = moe_ffn(jnp.concatenate([h2x, h2c], axis=0),
                    w_router, b_router, w_gu, b_gu, w_down, b_down)
        x = x + g2x * y[:B * L].reshape(B, L, D)
        ctx = ctx + g2c * y[B * L:].reshape(B, Lc, D)
    else:
        y = moe_ffn(h2x, w_router, b_router, w_gu, b_gu, w_down, b_down)
        x = x + g2x * y.reshape(B, L, D)
    return x, ctx


def setup_inputs(seed: int = 0) -> dict:
    key = jax.random.key(seed)
    ks = jax.random.split(key, 24)

    def nrm(k, shape, scale):
        return jax.random.normal(k, shape, jnp.float32) * scale

    D = D_MODEL
    return {
        'x': nrm(ks[0], (BATCH, SEQ, D), 1.0),
        'c': nrm(ks[1], (BATCH, D), 1.0),
        'ctx': nrm(ks[2], (BATCH, CTX_LEN, D), 1.0),
        'c_ctx': nrm(ks[3], (D,), 1.0),
        'w_ada': nrm(ks[4], (DEPTH, D, 6 * D), 0.5 * D ** -0.5),
        'b_ada': nrm(ks[5], (DEPTH, 6 * D), 0.02),
        'norm1_g': 1.0 + nrm(ks[6], (DEPTH, D), 0.02),
        'norm2_g': 1.0 + nrm(ks[7], (DEPTH, D), 0.02),
        'w_in': nrm(ks[8], (DEPTH, D, IN_W), D ** -0.5),
        'b_in': nrm(ks[9], (DEPTH, IN_W), 0.02),
        'attn_sink': nrm(ks[10], (DEPTH, N_HEADS), 0.5),
        'w_pool': nrm(ks[11], (DEPTH, N_POOL_GROUPS, POOL_GROUP_W, POOL_GROUP_W), POOL_GROUP_W ** -0.5),
        'pool_scale': 1.0 + nrm(ks[12], (DEPTH, POOL_W), 0.02),
        'w_attn_br': nrm(ks[13], (DEPTH, ATTN_W, D), ATTN_W ** -0.5),
        'w_pool_br': nrm(ks[14], (DEPTH, POOL_W, D), POOL_W ** -0.5),
        'w_out': nrm(ks[15], (DEPTH, D, D), D ** -0.5),
        'w_router': nrm(ks[16], (DEPTH, D, N_EXPERTS), D ** -0.5),
        'b_router': nrm(ks[17], (DEPTH, N_EXPERTS), 0.01),
        'w_gu': nrm(ks[18], (DEPTH, N_EXPERTS, D, 2 * D_FF), D ** -0.5),
        'b_gu': nrm(ks[19], (DEPTH, N_EXPERTS, 2 * D_FF), 0.02),
        'w_down': nrm(ks[20], (DEPTH, N_EXPERTS, D_FF, D), D_FF ** -0.5),
        'b_down': nrm(ks[21], (DEPTH, N_EXPERTS, D), 0.02),
        'final_g': 1.0 + nrm(ks[22], (D,), 0.02),
    }


def reference(x, c, ctx, c_ctx, w_ada, b_ada, norm1_g, norm2_g, w_in, b_in, attn_sink,
              w_pool, pool_scale, w_attn_br, w_pool_br, w_out, w_router, b_router,
              w_gu, b_gu, w_down, b_down, final_g):
    L = x.shape[1]
    ROWS = L // GRID_W
    row = jnp.broadcast_to(jnp.arange(ROWS, dtype=jnp.float32)[:, None], (ROWS, GRID_W)).reshape(-1)
    col = jnp.broadcast_to(jnp.arange(GRID_W, dtype=jnp.float32)[None, :], (ROWS, GRID_W)).reshape(-1)
    inv_freq = ROPE_BASE ** (-jnp.arange(ROPE_PAIRS, dtype=jnp.float32) / ROPE_PAIRS)
    ang = jnp.stack([row[:, None] * inv_freq, col[:, None] * inv_freq], axis=1)
    rope_cos, rope_sin = jnp.cos(ang), jnp.sin(ang)
    for i in range(DEPTH):
        x, ctx = hybrid_layer(
            x, ctx, rope_cos, rope_sin, c, c_ctx, w_ada[i], b_ada[i], norm1_g[i], norm2_g[i],
            w_in[i], b_in[i], attn_sink[i], w_pool[i], pool_scale[i], w_attn_br[i],
            w_pool_br[i], w_out[i], w_router[i], b_router[i], w_gu[i], b_gu[i],
            w_down[i], b_down[i], update_ctx=(i + 1 < DEPTH))
    return rmsnorm(x, final_g)
```

```cpp
#define MK_N_LAUNCHES 10
#include <hip/hip_runtime.h>
#include <hip/hip_bf16.h>
#include <cstdio>
#include <cstdint>
#include <cmath>

typedef float f32x2_t __attribute__((ext_vector_type(2))); typedef __bf16 bf16x2_t __attribute__((ext_vector_type(2)));
__device__ __forceinline__ unsigned pk2(float lo, float hi) { f32x2_t v = {lo, hi}; bf16x2_t b = __builtin_convertvector(v, bf16x2_t); return __builtin_bit_cast(unsigned, b); }
__device__ __forceinline__ float bflo(unsigned w) { return __uint_as_float(w << 16); }
__device__ __forceinline__ float bfhi(unsigned w) { return __uint_as_float(w & 0xffff0000u); }
__device__ __forceinline__ float fsigmoid(float x) { return __builtin_amdgcn_rcpf(1.0f + __builtin_amdgcn_exp2f(-1.4426950408889634f * x)); }
constexpr float ATT_C2 = 0.125f * 1.4426950408889634f;

namespace pg8 {
#define PG8_LAS __attribute__((address_space(3)))
typedef unsigned short bf16_t;
typedef short bf16x8 __attribute__((ext_vector_type(8)));
typedef float f32x4 __attribute__((ext_vector_type(4)));
typedef unsigned u32x4 __attribute__((ext_vector_type(4)));
typedef unsigned u32x2 __attribute__((ext_vector_type(2)));
constexpr int BM = 256, BK = 64, HALF = 128, HTB = HALF * BK * 2  , STAGE_BYTES = 8 * HTB, NXCD = 8, WGM = 8;

__host__ __device__ __forceinline__ int lds_byte(int r, int c) { const int st = (r >> 4) * 2 + (c >> 5), rr = r & 15, cc = c & 31, ob = rr * 64 + cc * 2; return st * 1024 + (ob ^ (((ob >> 9) & 1) << 5)); }
__host__ __device__ __forceinline__ void stage_rc(int b, int& R, int& C) { const int st = b / 1024, sb = b % 1024, swz = sb ^ (((sb >> 9) & 1) << 5); R = (st >> 1) * 16 + swz / 64; C = (st & 1) * 32 + (swz % 64) / 2; }
__host__ __device__ __forceinline__ int perm32(int rho) { const int n = rho >> 4, i = rho & 15; return 8 * (i >> 2) + 4 * n + (i & 3); }

struct Unit { int pm, pn; const char* a; const char* b; int x0, x1; };

__host__ __device__ __forceinline__ int xcd_remap(int wgid, int nwg) { const int q = nwg / NXCD, r = nwg % NXCD, xcd = wgid % NXCD, off = wgid / NXCD; return (xcd < r ? xcd * (q + 1) : r * (q + 1) + (xcd - r) * q) + off; }
__host__ __device__ __forceinline__ void tile_map(int wgid, int nM, int nN, int& pm, int& pn) {
    const int nig = WGM * nN, gid = wgid / nig, fm = gid * WGM, gsz = (nM - fm) < WGM ? (nM - fm) : WGM;
    pm = fm + ((wgid % nig) % gsz); pn = (wgid % nig) / gsz;
}

template <class Epi, class Sched, bool ALIGN_EPI, bool GATHER>
__device__ __forceinline__ void gemm_phase(PG8_LAS unsigned char* lds, const int K, const int lda, const Sched& S, const Epi& E) {
    const int tid = threadIdx.x, wid = __builtin_amdgcn_readfirstlane(tid >> 6), lane = tid & 63, wr = wid >> 2, wc = wid & 3, fr = lane & 15, fq = lane >> 4;
    const int nt = K / BK;
    int RA[2], CA[2]; unsigned voffB[2];
#pragma unroll
    for (int i = 0; i < 2; ++i) { int R, C; stage_rc(tid * 16 + i * 8192, R, C); const int Rb = Epi::PERM ? ((R & ~31) + perm32(R & 31)) : R;
        RA[i] = R; CA[i] = C; voffB[i] = (unsigned)(Rb * K + C) * 2u; }
    const size_t kstep = (size_t)(BK * 2);
    const size_t hstepB = (size_t)HALF * K * 2;
    const unsigned ldsw = (unsigned)wid * 1024u;
    const int aoff = lds_byte(wr * 64 + fr, fq * 8), boff = lds_byte(wc * 32 + fr, fq * 8);
#define PG8_SA(b, h) (((b) * 2 + (h)) * HTB)
#define PG8_SB(b, h) ((4 + (b) * 2 + (h)) * HTB)
#define PG8_STAGE(bufoff, gbase, v0, v1) do { \
        __builtin_amdgcn_global_load_lds((const unsigned*)((const char*)(gbase) + (v0)), (PG8_LAS unsigned*)(lds + (bufoff) + ldsw), 16, 0, 0); \
        __builtin_amdgcn_global_load_lds((const unsigned*)((const char*)(gbase) + (v1)), (PG8_LAS unsigned*)(lds + (bufoff) + ldsw + 8192), 16, 0, 0); } while (0)
#define PG8_LDA(dst, b, h) do { _Pragma("unroll") for (int m = 0; m < 4; ++m) _Pragma("unroll") for (int k = 0; k < 2; ++k) dst[m][k] = *(const PG8_LAS bf16x8*)(lds + PG8_SA(b, h) + aoff + m * 2048 + k * 1024); } while (0)
#define PG8_LDB(dst, b, h) do { _Pragma("unroll") for (int n = 0; n < 2; ++n) _Pragma("unroll") for (int k = 0; k < 2; ++k) dst[n][k] = *(const PG8_LAS bf16x8*)(lds + PG8_SB(b, h) + boff + n * 2048 + k * 1024); } while (0)
#define PG8_MMA(ai, bj, At, Bt) do { __builtin_amdgcn_s_setprio(1); _Pragma("unroll") for (int m = 0; m < 4; ++m) _Pragma("unroll") for (int n = 0; n < 2; ++n) _Pragma("unroll") for (int k = 0; k < 2; ++k) \
        acc[ai][bj][m][n] = __builtin_amdgcn_mfma_f32_16x16x32_bf16(Bt[n][k], At[m][k], acc[ai][bj][m][n], 0, 0, 0); __builtin_amdgcn_s_setprio(0); } while (0)
#define PG8_WAIT_V(n) asm volatile("s_waitcnt vmcnt(" #n ")" ::: "memory")
#define PG8_WAIT_L(n) asm volatile("s_waitcnt lgkmcnt(" #n ")" ::: "memory")
#define PG8_BAR __builtin_amdgcn_s_barrier()
#define PG8_SCHED __builtin_amdgcn_sched_barrier(0)
#define PG8_AVOFF(dst, u) do { _Pragma("unroll") for (int h_ = 0; h_ < 2; ++h_) _Pragma("unroll") for (int i_ = 0; i_ < 2; ++i_) { \
        const unsigned row_ = GATHER ? S.a_row((u), h_ * HALF + RA[i_]) : (unsigned)(h_ * HALF + RA[i_]); dst[h_][i_] = (row_ * (unsigned)lda + (unsigned)CA[i_]) * 2u; } } while (0)
    Unit cur, nxt; int ui = 0;
    if (!S.next(0, cur)) return;
    f32x4 acc[2][2][4][2];
#pragma unroll
    for (int a = 0; a < 2; ++a)
#pragma unroll
        for (int b = 0; b < 2; ++b)
#pragma unroll
            for (int m = 0; m < 4; ++m)
#pragma unroll
                for (int n = 0; n < 2; ++n) acc[a][b][m][n] = (f32x4){0.f, 0.f, 0.f, 0.f};
    bf16x8 At[4][2], B0[2][2], B1[2][2];
    unsigned vA[2][2], vN[2][2];
    PG8_AVOFF(vA, cur);
    const char* cA = cur.a; const char* cB = cur.b;
    PG8_STAGE(PG8_SB(0, 0), cB, voffB[0], voffB[1]); PG8_STAGE(PG8_SB(0, 1), cB + hstepB, voffB[0], voffB[1]); PG8_STAGE(PG8_SA(0, 0), cA, vA[0][0], vA[0][1]); PG8_STAGE(PG8_SA(0, 1), cA, vA[1][0], vA[1][1]);
    if (wr == 1) PG8_BAR;
    PG8_WAIT_V(2); PG8_BAR;
    PG8_STAGE(PG8_SB(1, 0), cB + kstep, voffB[0], voffB[1]); PG8_STAGE(PG8_SA(1, 0), cA + kstep, vA[0][0], vA[0][1]); PG8_STAGE(PG8_SB(1, 1), cB + hstepB + kstep, voffB[0], voffB[1]);
    PG8_WAIT_V(6); PG8_BAR;
    for (;;) {
        const bool has_next = S.next(ui + 1, nxt);
        const char* nA = has_next ? nxt.a : cA; const char* nB = has_next ? nxt.b : cB;
        if (GATHER) { if (has_next) { PG8_AVOFF(vN, nxt); } else {
#pragma unroll
            for (int h_ = 0; h_ < 2; ++h_)
#pragma unroll
                for (int i_ = 0; i_ < 2; ++i_) vN[h_][i_] = vA[h_][i_]; } }
        for (int t = 0; t < nt; t += 2) {
            const bool last = (t == nt - 2);
            const char* a1 = cA + (size_t)(t + 1) * kstep;
            const char* a2 = last ? nA : cA + (size_t)(t + 2) * kstep; const char* b2 = last ? nB : cB + (size_t)(t + 2) * kstep;
            const char* a3 = a2 + kstep; const char* b3 = b2 + kstep;
            unsigned s00, s01, s10, s11;
            if (GATHER) { s00 = last ? vN[0][0] : vA[0][0]; s01 = last ? vN[0][1] : vA[0][1]; s10 = last ? vN[1][0] : vA[1][0]; s11 = last ? vN[1][1] : vA[1][1]; }
            else { s00 = vA[0][0]; s01 = vA[0][1]; s10 = vA[1][0]; s11 = vA[1][1]; }
            PG8_LDB(B0, 0, 0); PG8_LDB(B1, 0, 1); PG8_SCHED; PG8_LDA(At, 0, 0); PG8_STAGE(PG8_SA(1, 1), a1, vA[1][0], vA[1][1]);
            PG8_WAIT_V(8); PG8_WAIT_L(0); PG8_BAR; PG8_MMA(0, 0, At, B0); PG8_MMA(0, 1, At, B1); PG8_BAR; PG8_SCHED;
            PG8_LDA(At, 0, 1); PG8_STAGE(PG8_SB(0, 0), b2, voffB[0], voffB[1]); PG8_STAGE(PG8_SB(0, 1), b2 + hstepB, voffB[0], voffB[1]); PG8_STAGE(PG8_SA(0, 0), a2, s00, s01);
            PG8_WAIT_V(8); PG8_WAIT_L(0); PG8_BAR; PG8_MMA(1, 0, At, B0); PG8_MMA(1, 1, At, B1); PG8_BAR; PG8_SCHED;
            PG8_LDB(B0, 1, 0); PG8_LDB(B1, 1, 1); PG8_SCHED; PG8_LDA(At, 1, 0); PG8_STAGE(PG8_SA(0, 1), a2, s10, s11);
            PG8_WAIT_V(8); PG8_WAIT_L(0); PG8_BAR; PG8_MMA(0, 0, At, B0); PG8_MMA(0, 1, At, B1); PG8_BAR; PG8_SCHED;
            PG8_LDA(At, 1, 1); PG8_STAGE(PG8_SB(1, 0), b3, voffB[0], voffB[1]); PG8_STAGE(PG8_SB(1, 1), b3 + hstepB, voffB[0], voffB[1]); PG8_STAGE(PG8_SA(1, 0), a3, s00, s01);
            PG8_WAIT_V(8); PG8_WAIT_L(0); PG8_BAR; PG8_MMA(1, 0, At, B0); PG8_MMA(1, 1, At, B1); PG8_BAR; PG8_SCHED;
        }
        if constexpr (ALIGN_EPI) { if (wr == 0) PG8_BAR; }
        const bool keep = E(acc, cur, wr, wc, fr, fq);
        if (!has_next) break;
        if (!(Epi::MAY_KEEP && keep)) {
#pragma unroll
        for (int a = 0; a < 2; ++a)
#pragma unroll
            for (int b = 0; b < 2; ++b)
#pragma unroll
                for (int m = 0; m < 4; ++m)
#pragma unroll
                    for (int n = 0; n < 2; ++n) acc[a][b][m][n] = (f32x4){0.f, 0.f, 0.f, 0.f};
        }
        cur = nxt; cA = nA; cB = nB; ++ui;
        if (GATHER) {
#pragma unroll
            for (int h_ = 0; h_ < 2; ++h_)
#pragma unroll
                for (int i_ = 0; i_ < 2; ++i_) vA[h_][i_] = vN[h_][i_]; }
        if constexpr (ALIGN_EPI) { if (wr == 1) PG8_BAR; }
    }
    PG8_WAIT_V(0);
    if constexpr (!ALIGN_EPI) { if (wr == 0) PG8_BAR; }
    PG8_BAR;
#undef PG8_SA
#undef PG8_SB
#undef PG8_STAGE
#undef PG8_LDA
#undef PG8_LDB
#undef PG8_MMA
#undef PG8_WAIT_V
#undef PG8_WAIT_L
#undef PG8_BAR
#undef PG8_SCHED
#undef PG8_AVOFF
}
}
namespace pg8 {
constexpr size_t TSTEP = (size_t)256 * 1024 * 2;

struct OrdStatic {
    int nM, nN, nwg, G, c; const char *A, *B;
    __device__ __forceinline__ void init(int M, int N, int G_, int c_, const void* A_, const void* B_) { nM = M / BM; nN = N / BM; nwg = nM * nN; G = G_; c = c_; A = (const char*)A_; B = (const char*)B_; }
    __device__ __forceinline__ bool next(int i, Unit& u) const {
        const long L = (long)i * G + c; if (L >= nwg) return false;
        tile_map(xcd_remap((int)L, nwg), nM, nN, u.pm, u.pn); u.a = A + (size_t)u.pm * TSTEP; u.b = B + (size_t)u.pn * TSTEP; u.x0 = 0; u.x1 = 0; return true;
    }
    __device__ __forceinline__ unsigned a_row(const Unit&, int r) const { return (unsigned)r; }
};
struct OrdInProj {
    int G, c; const char *A, *B;
    static constexpr int nM = 64, nN = 18, nwg = nM * nN;
    __device__ __forceinline__ bool next(int i, Unit& u) const {
        long L = (long)i * G + c;
        if (L < nwg) { tile_map(xcd_remap((int)L, nwg), nM, nN, u.pm, u.pn); u.a = A + (size_t)u.pm * TSTEP; u.b = B + (size_t)u.pn * TSTEP; u.x0 = 0; u.x1 = 0; return true; }
        L -= nwg; if (L >= 4) return false;
        u.pm = (int)(L >> 1); u.pn = 4 + (int)(L & 1); u.a = A + (size_t)(64 + u.pm) * TSTEP; u.b = B + (size_t)u.pn * TSTEP; u.x0 = 1; u.x1 = 0; return true;
    }
    __device__ __forceinline__ unsigned a_row(const Unit&, int r) const { return (unsigned)r; }
};
struct OrdMerge {
    int G, c; const char *A0, *A1, *B0, *B1;
    static constexpr int nM = 64, nN = 4, nwg = nM * nN;
    __device__ __forceinline__ bool next(int i, Unit& u) const {
        const long L = (long)(i >> 1) * G + c; if (L >= nwg) return false;
        tile_map(xcd_remap((int)L, nwg), nM, nN, u.pm, u.pn); const int p = i & 1;
        u.a = (p ? A1 : A0) + (size_t)u.pm * TSTEP; u.b = (p ? B1 : B0) + (size_t)u.pn * TSTEP; u.x0 = p; u.x1 = 0; return true;
    }
    __device__ __forceinline__ unsigned a_row(const Unit&, int r) const { return (unsigned)r; }
};
struct OrdMoe {
    int G, c, nN; const volatile PG8_LAS int* pt; const volatile PG8_LAS int* cn; const char *A, *B; size_t bstride; const int* list; int gather;
    __device__ __forceinline__ bool next(int i, Unit& u) const {
        const int total = pt[32] * nN; const long L = (long)i * G + c; if (L >= total) return false;
        const int w = xcd_remap((int)L, total);
        int e = 0;
#pragma unroll 1
        for (int j = 1; j < 32; ++j) if (w >= pt[j] * nN) e = j;
        const int p0 = pt[e], te = pt[e + 1] - p0, loc = w - p0 * nN;
        u.pn = loc / te; const int mt = loc - u.pn * te; u.pm = p0 + mt; u.x0 = e; u.x1 = mt;
        u.a = gather ? A : A + (size_t)u.pm * TSTEP; u.b = B + (size_t)e * bstride + (size_t)u.pn * TSTEP; return true;
    }
    __device__ __forceinline__ unsigned a_row(const Unit& u, int r) const { const int rr = u.x1 * 256 + r; return rr < cn[u.x0] ? (unsigned)(list[u.x0 * 16384 + rr] >> 2) : 0u; }
};

struct EpiInProj {
    static constexpr bool PERM = false, MAY_KEEP = false;
    const float* bias; bf16_t *Q, *Kx, *U; size_t kv_stride, u_stride; const float *rc, *rs;
    __device__ __forceinline__ bool operator()(f32x4 (&acc)[2][2][4][2], const Unit& u, int wr, int wc, int fr, int fq) const {
        const int pn = u.pn, ctx = u.x0, ct = wc * 32 + 4 * fq;
        f32x4 bv[2][2];
#pragma unroll
        for (int bj = 0; bj < 2; ++bj)
#pragma unroll
            for (int n = 0; n < 2; ++n) bv[bj][n] = *(const f32x4*)(bias + pn * 256 + bj * HALF + ct + 16 * n);
        if (pn < 6) {
#pragma unroll
            for (int ai = 0; ai < 2; ++ai)
#pragma unroll
                for (int m = 0; m < 4; ++m) {
                    const int rt = u.pm * BM + ai * HALF + wr * 64 + m * 16 + fr;
                    int b, l; if (ctx) { b = rt >> 8; l = rt & 255; } else { b = rt >> 13; l = rt & 8191; }
                    bf16_t* dst; float sc = 1.f; bool rope;
                    if (pn < 4) { dst = Q + (size_t)rt * 1024 + pn * 256; sc = ATT_C2; rope = true; }
                    else { const size_t erow = (size_t)b * 8448 + (ctx ? l : 256 + l); dst = Kx + (size_t)(pn - 4) * kv_stride + erow * 256; rope = (pn == 4) && !ctx; }
                    f32x4 cs = (f32x4){1.f, 1.f, 1.f, 1.f}, sn = (f32x4){0.f, 0.f, 0.f, 0.f};
                    if (rope) { const int ti = (wc & 1) ? 128 + (l & 63) : (l >> 6); cs = *(const f32x4*)(rc + ti * 16 + 4 * fq); sn = *(const f32x4*)(rs + ti * 16 + 4 * fq); }
#pragma unroll
                    for (int bj = 0; bj < 2; ++bj) {
                        const f32x4 t1 = acc[ai][bj][m][0] + bv[bj][0], t2 = acc[ai][bj][m][1] + bv[bj][1];
                        const f32x4 o1 = (t1 * cs - t2 * sn) * sc, o2 = (t2 * cs + t1 * sn) * sc;
                        u32x2 w1, w2; w1.x = pk2(o1[0], o1[1]); w1.y = pk2(o1[2], o1[3]); w2.x = pk2(o2[0], o2[1]); w2.y = pk2(o2[2], o2[3]);
                        *(u32x2*)(dst + bj * HALF + ct) = w1; *(u32x2*)(dst + bj * HALF + ct + 16) = w2;
                    }
                }
        } else {
            const int sel = (pn - 6) >> 2, cb = ((pn - 6) & 3) * 256; bf16_t* base = U + (size_t)sel * u_stride;
#pragma unroll
            for (int ai = 0; ai < 2; ++ai)
#pragma unroll
                for (int m = 0; m < 4; ++m) {
                    bf16_t* dst = base + (size_t)(u.pm * BM + ai * HALF + wr * 64 + m * 16 + fr) * 1024 + cb;
#pragma unroll
                    for (int bj = 0; bj < 2; ++bj)
#pragma unroll
                        for (int n = 0; n < 2; ++n) {
                            f32x4 v = acc[ai][bj][m][n] + bv[bj][n];
                            if (sel) { v[0] = fsigmoid(v[0]); v[1] = fsigmoid(v[1]); v[2] = fsigmoid(v[2]); v[3] = fsigmoid(v[3]); }
                            u32x2 w; w.x = pk2(v[0], v[1]); w.y = pk2(v[2], v[3]); *(u32x2*)(dst + bj * HALF + ct + 16 * n) = w;
                        }
                }
        }
        return false;
    }
};
struct EpiMerge {
    static constexpr bool PERM = true, MAY_KEEP = true;
    const bf16_t *SA, *SP; bf16_t* O;
    __device__ __forceinline__ bool operator()(f32x4 (&acc)[2][2][4][2], const Unit& u, int wr, int wc, int fr, int fq) const {
        const int col0 = u.pn * BM + wc * 32 + 8 * fq;
#pragma unroll
        for (int ai = 0; ai < 2; ++ai)
#pragma unroll
            for (int m = 0; m < 4; ++m) {
                const size_t off = (size_t)(u.pm * BM + ai * HALF + wr * 64 + m * 16 + fr) * 1024 + col0;
#pragma unroll
                for (int bj = 0; bj < 2; ++bj) {
                    const u32x4 gp = *(const u32x4*)(SP + off + bj * HALF);
                    float sp[8] = {bflo(gp.x), bfhi(gp.x), bflo(gp.y), bfhi(gp.y), bflo(gp.z), bfhi(gp.z), bflo(gp.w), bfhi(gp.w)};
                    if (u.x0 == 0) {
                        const u32x4 ga = *(const u32x4*)(SA + off + bj * HALF);
                        float sa[8] = {bflo(ga.x), bfhi(ga.x), bflo(ga.y), bfhi(ga.y), bflo(ga.z), bfhi(ga.z), bflo(ga.w), bfhi(ga.w)};
#pragma unroll
                        for (int n = 0; n < 2; ++n)
#pragma unroll
                            for (int i = 0; i < 4; ++i) acc[ai][bj][m][n][i] *= sa[4 * n + i] * __builtin_amdgcn_rcpf(fmaxf(sp[4 * n + i], 1e-30f));
                    } else {
                        f32x4 v0 = acc[ai][bj][m][0], v1 = acc[ai][bj][m][1];
#pragma unroll
                        for (int i = 0; i < 4; ++i) { v0[i] *= fmaxf(sp[i], 1e-30f); v1[i] *= fmaxf(sp[4 + i], 1e-30f); }
                        u32x4 w; w.x = pk2(v0[0], v0[1]); w.y = pk2(v0[2], v0[3]); w.z = pk2(v1[0], v1[1]); w.w = pk2(v1[2], v1[3]);
                        *(u32x4*)(O + off + bj * HALF) = w;
                    }
                }
            }
        return u.x0 == 0;
    }
};
struct EpiOut {
    static constexpr bool PERM = true, MAY_KEEP = false;
    const float* x; const float* modx; float* out;
    __device__ __forceinline__ bool operator()(f32x4 (&acc)[2][2][4][2], const Unit& u, int wr, int wc, int fr, int fq) const {
        const int col0 = u.pn * BM + wc * 32 + 8 * fq; const int b = (u.pm * BM) >> 13;
        f32x4 g[2][2];
#pragma unroll
        for (int bj = 0; bj < 2; ++bj)
#pragma unroll
            for (int n = 0; n < 2; ++n) g[bj][n] = *(const f32x4*)(modx + b * 6144 + 2048 + col0 + bj * HALF + 4 * n);
#pragma unroll
        for (int ai = 0; ai < 2; ++ai)
#pragma unroll
            for (int m = 0; m < 4; ++m) {
                const size_t off = (size_t)(u.pm * BM + ai * HALF + wr * 64 + m * 16 + fr) * 1024 + col0;
#pragma unroll
                for (int bj = 0; bj < 2; ++bj)
#pragma unroll
                    for (int n = 0; n < 2; ++n) { const f32x4 xv = *(const f32x4*)(x + off + bj * HALF + 4 * n); *(f32x4*)(out + off + bj * HALF + 4 * n) = xv + g[bj][n] * acc[ai][bj][m][n]; }
            }
        return false;
    }
};
struct EpiSwiglu {
    static constexpr bool PERM = true, MAY_KEEP = false;
    const float* bgu; bf16_t* ACT;
    __device__ __forceinline__ bool operator()(f32x4 (&acc)[2][2][4][2], const Unit& u, int wr, int wc, int fr, int fq) const {
        const int ca = u.pn * HALF + wc * 32 + 8 * fq; const float* be = bgu + (size_t)u.x0 * 2048;
        f32x4 bg[2], bl[2];
#pragma unroll
        for (int n = 0; n < 2; ++n) { bg[n] = *(const f32x4*)(be + ca + 4 * n); bl[n] = *(const f32x4*)(be + 1024 + ca + 4 * n); }
#pragma unroll
        for (int ai = 0; ai < 2; ++ai)
#pragma unroll
            for (int m = 0; m < 4; ++m) {
                bf16_t* dst = ACT + (size_t)(u.pm * BM + ai * HALF + wr * 64 + m * 16 + fr) * 1024 + ca;
                float o[8];
#pragma unroll
                for (int n = 0; n < 2; ++n)
#pragma unroll
                    for (int i = 0; i < 4; ++i) {
                        const float gt = fminf(acc[ai][0][m][n][i] + bg[n][i], 7.0f);
                        const float ln = fminf(fmaxf(acc[ai][1][m][n][i] + bl[n][i], -7.0f), 7.0f);
                        o[4 * n + i] = gt * fsigmoid(1.702f * gt) * (ln + 1.0f);
                    }
                u32x4 w; w.x = pk2(o[0], o[1]); w.y = pk2(o[2], o[3]); w.z = pk2(o[4], o[5]); w.w = pk2(o[6], o[7]);
                *(u32x4*)dst = w;
            }
        return false;
    }
};
struct EpiDown {
    static constexpr bool PERM = true, MAY_KEEP = false;
    const float* bd; bf16_t* Y2; const int* list; const volatile PG8_LAS int* cn;
    __device__ __forceinline__ bool operator()(f32x4 (&acc)[2][2][4][2], const Unit& u, int wr, int wc, int fr, int fq) const {
        const int col0 = u.pn * BM + wc * 32 + 8 * fq; const float* be = bd + (size_t)u.x0 * 1024; const int cnt = cn[u.x0];
        f32x4 bv[2][2];
#pragma unroll
        for (int bj = 0; bj < 2; ++bj)
#pragma unroll
            for (int n = 0; n < 2; ++n) bv[bj][n] = *(const f32x4*)(be + col0 + bj * HALF + 4 * n);
#pragma unroll
        for (int ai = 0; ai < 2; ++ai)
#pragma unroll
            for (int m = 0; m < 4; ++m) {
                const int rr = u.x1 * 256 + ai * HALF + wr * 64 + m * 16 + fr;
                if (rr < cnt) {
                    const int ent = list[u.x0 * 16384 + rr]; bf16_t* dst = Y2 + (size_t)ent * 1024 + col0;
#pragma unroll
                    for (int bj = 0; bj < 2; ++bj) { const f32x4 v0 = acc[ai][bj][m][0] + bv[bj][0], v1 = acc[ai][bj][m][1] + bv[bj][1];
                        u32x4 w; w.x = pk2(v0[0], v0[1]); w.y = pk2(v0[2], v0[3]); w.z = pk2(v1[0], v1[1]); w.w = pk2(v1[2], v1[3]); *(u32x4*)(dst + bj * HALF) = w; }
                }
            }
        return false;
    }
};
}
namespace attn_body {
using bf16=__hip_bfloat16;
using bf16x8=__attribute__((ext_vector_type(8)))short;
using s16x4=__attribute__((ext_vector_type(4)))short;
using f32x16=__attribute__((ext_vector_type(16)))float;
using u32x4=__attribute__((ext_vector_type(4)))unsigned;
constexpr int BATCH=2,NHEAD=16,SEQ=8192,D=64,DM=NHEAD*D;
constexpr int NW=8,QBLK=32,QB=QBLK*NW,KVBLK=64,NQB=SEQ/QB;
constexpr int ATTN_PITCH=DM, ATTN_UNIT_ROWS=QB;
constexpr int KP=256, KVROWS=8448, CTXT=4;
__device__ __forceinline__ int crow(int r,int hi){return (r&3)+8*(r>>2)+4*hi;}
#define SBAR() __builtin_amdgcn_sched_barrier(0)
__device__ __forceinline__ void cmask(f32x16&p0,f32x16&p1,int db,int hi){
  const float NEG=-INFINITY; const int kb=db+4*hi;
  #pragma unroll
  for(int r=0;r<16;++r){const int kv=kb+(r&3)+8*(r>>2); if((unsigned)kv>256u)p0[r]=NEG; if((unsigned)(kv+32)>256u)p1[r]=NEG;}
}

constexpr int NSLOT=3, SLOTB=8192;
constexpr int LDS_K=0, LDS_V=NSLOT*SLOTB, LDS_WS=2*NSLOT*SLOTB, LDS_OST=LDS_WS+NW*64*4, LDS_BYTES=LDS_OST+NW*4096;
constexpr float C2=0.125f*1.4426950408889634f;
__device__ __forceinline__ void glds16(const void*gsrc,unsigned lds_dst){unsigned keep;
  asm volatile("s_mov_b32 %0, m0\n\ts_mov_b32 m0, %2\n\ts_nop 0\n\tglobal_load_lds_dwordx4 %1, off\n\ts_mov_b32 m0, %0":"=&s"(keep):"v"(gsrc),"s"(lds_dst):"memory");}
__device__ __forceinline__ float max3f(float a,float b,float c){float r;asm("v_max3_f32 %0, %1, %2, %3":"=v"(r):"v"(a),"v"(b),"v"(c));return r;}
__device__ __forceinline__ float max2f(float a,float b){float r;asm("v_max_f32_e32 %0, %1, %2":"=v"(r):"v"(a),"v"(b));return r;}
__device__ __forceinline__ float fadd_s(float a,float b){float r;asm("v_add_f32_e32 %0, %1, %2":"=v"(r):"v"(a),"v"(b));return r;}
__device__ __forceinline__ float fsub_s(float a,float b){float r;asm("v_sub_f32_e32 %0, %1, %2":"=v"(r):"v"(a),"v"(b));return r;}
typedef float f32x2_t __attribute__((ext_vector_type(2))); typedef __bf16 bf16x2_t __attribute__((ext_vector_type(2)));
__device__ __forceinline__ unsigned cvtpk_s(float lo,float hi){f32x2_t v={lo,hi};bf16x2_t b=__builtin_convertvector(v,bf16x2_t);return __builtin_bit_cast(unsigned,b);}
#define WAIT_BAR(N) asm volatile("s_waitcnt vmcnt(" #N ") lgkmcnt(0)\n\ts_barrier":::"memory")

__device__ __forceinline__ void qkt(f32x16&p0,f32x16&p1,const char*Kslot,const bf16x8*qr,const f32x16&negm,int r32,int hi){
  const char*kb=Kslot+hi*1024+r32*16;
  #pragma unroll
  for(int d0=0;d0<4;++d0){
    const bf16x8 b0=*reinterpret_cast<const bf16x8*>(kb+d0*2048);
    const bf16x8 b1=*reinterpret_cast<const bf16x8*>(kb+d0*2048+512);
    if(d0==0){p0=__builtin_amdgcn_mfma_f32_32x32x16_bf16(b0,qr[0],negm,0,0,0);p1=__builtin_amdgcn_mfma_f32_32x32x16_bf16(b1,qr[0],negm,0,0,0);}
    else{p0=__builtin_amdgcn_mfma_f32_32x32x16_bf16(b0,qr[d0],p0,0,0,0);p1=__builtin_amdgcn_mfma_f32_32x32x16_bf16(b1,qr[d0],p1,0,0,0);}}
}
typedef __attribute__((address_space(3))) const char* lds_cptr;
typedef short v4i16_t __attribute__((ext_vector_type(4)));
__device__ __forceinline__ void kload8(bf16x8*kf,lds_cptr kp){
  kf[0]=*(const __attribute__((address_space(3))) bf16x8*)(kp);      kf[1]=*(const __attribute__((address_space(3))) bf16x8*)(kp+512);
  kf[2]=*(const __attribute__((address_space(3))) bf16x8*)(kp+2048); kf[3]=*(const __attribute__((address_space(3))) bf16x8*)(kp+2560);
  kf[4]=*(const __attribute__((address_space(3))) bf16x8*)(kp+4096); kf[5]=*(const __attribute__((address_space(3))) bf16x8*)(kp+4608);
  kf[6]=*(const __attribute__((address_space(3))) bf16x8*)(kp+6144); kf[7]=*(const __attribute__((address_space(3))) bf16x8*)(kp+6656);
}
__device__ __forceinline__ void kload2(bf16x8*kf,lds_cptr kp,int j){ kf[2*j]=*(const __attribute__((address_space(3))) bf16x8*)(kp+j*2048); kf[2*j+1]=*(const __attribute__((address_space(3))) bf16x8*)(kp+j*2048+512); }
__device__ __forceinline__ s16x4 vtr(lds_cptr p){ return __builtin_bit_cast(s16x4,__builtin_amdgcn_ds_read_tr16_b64_v4i16((__attribute__((address_space(3))) v4i16_t*)p)); }
__device__ __forceinline__ float rowmax(const f32x16&p0,const f32x16&p1){
  float a=max3f(p0[0],p0[1],p1[0]),b=max3f(p0[2],p0[3],p1[1]);a=max3f(a,p1[2],p1[3]);
  #pragma unroll
  for(int r=4;r<16;r+=4){a=max3f(a,p0[r],p0[r+1]);b=max3f(b,p0[r+2],p0[r+3]);a=max3f(a,p1[r],p1[r+1]);b=max3f(b,p1[r+2],p1[r+3]);}
  const float m=max2f(a,b);
  auto rr=__builtin_amdgcn_permlane32_swap(__float_as_uint(m),__float_as_uint(m),false,false);
  return max2f(__uint_as_float(rr[0]),__uint_as_float(rr[1]));
}
__device__ __forceinline__ void pv(f32x16*o,int vb,bf16x8 pa0,bf16x8 pa1,bf16x8 pa2,bf16x8 pa3){
  #pragma unroll
  for(int d0=0;d0<2;++d0){s16x4 lo[4],hi[4];
    #pragma unroll
    for(int ks=0;ks<4;++ks){
      asm volatile("ds_read_b64_tr_b16 %0,%1 offset:%c2":"=&v"(lo[ks]):"v"(vb),"i"(d0*4096+ks*1024):"memory");
      asm volatile("ds_read_b64_tr_b16 %0,%1 offset:%c2":"=&v"(hi[ks]):"v"(vb),"i"(d0*4096+ks*1024+512):"memory");}
    asm volatile("s_waitcnt lgkmcnt(0)":::"memory");SBAR();
    #define PK(k) (bf16x8){lo[k][0],lo[k][1],lo[k][2],lo[k][3],hi[k][0],hi[k][1],hi[k][2],hi[k][3]}
    o[d0]=__builtin_amdgcn_mfma_f32_32x32x16_bf16(pa0,PK(0),o[d0],0,0,0);
    o[d0]=__builtin_amdgcn_mfma_f32_32x32x16_bf16(pa1,PK(1),o[d0],0,0,0);
    o[d0]=__builtin_amdgcn_mfma_f32_32x32x16_bf16(pa2,PK(2),o[d0],0,0,0);
    o[d0]=__builtin_amdgcn_mfma_f32_32x32x16_bf16(pa3,PK(3),o[d0],0,0,0);
    #undef PK
  }
}

#ifndef ATTN_STORE16
#define ATTN_STORE16(p,v) (*(u32x4*)(p)=(v))
#endif
template<int THRL> __device__ __forceinline__ void attn_unit(int b,int h,int qb,const bf16*Q,const bf16*__restrict__ K,const bf16*__restrict__ V,bf16*O,const float*sink,char*shm){
  const int tid=threadIdx.x,lane=tid&63,r32=lane&31,hi=lane>>5; const int wid=__builtin_amdgcn_readfirstlane(tid>>6);
  const long rowbase=(long)b*SEQ; const int q0=qb*QB;
  const bf16*Qw=Q+(rowbase+q0+wid*QBLK)*DM+h*D;
  const bf16*Kh=K+(long)b*KVROWS*KP+(h>>2)*D,*Vh=V+(long)b*KVROWS*KP+(h>>2)*D;
  const int jlo=(q0>=128)?(q0-128):0, jhi=(q0+384<=SEQ)?(q0+384):SEQ; const int TLO=CTXT+jlo/KVBLK;
  #define TIX(t) (((t)<CTXT)?(t):(TLO+(t)-CTXT))
  const unsigned lds0=(unsigned)(uintptr_t)shm;
  float*wsf=(float*)(shm+LDS_WS)+wid*64;
  const bf16*ksrc=Kh+(long)lane*KP+wid*8;
  const bf16*vsrc=Vh+(long)(16*(wid&3)+(lane>>2))*KP+(wid>>2)*32+(lane&3)*8;
  const unsigned kdst=lds0+LDS_K+wid*1024, vdst=lds0+LDS_V+wid*1024;
  #define DMA_K(t,slot) glds16(ksrc+(long)TIX(t)*KVBLK*KP,(unsigned)__builtin_amdgcn_readfirstlane(kdst+(slot)))
  #define DMA_V(t,slot) glds16(vsrc+(long)TIX(t)*KVBLK*KP,(unsigned)__builtin_amdgcn_readfirstlane(vdst+(slot)))
  const int vb0=(int)(lds0+LDS_V)+((lane>>4)&1)*32+(lane&3)*8+(4*hi+((lane&15)>>2))*64;
  const char*Kbase=shm+LDS_K; bf16x8 kf[8];
  const lds_cptr shm3=(lds_cptr)shm; const lds_cptr kp0=shm3+LDS_K+hi*1024+r32*16; const lds_cptr vp0=shm3+LDS_V+((lane>>4)&1)*32+(lane&3)*8+(4*hi+((lane&15)>>2))*64;
  const int NT=CTXT+(jhi-jlo)/KVBLK;
  DMA_K(0,0);DMA_V(0,0);DMA_K(1,SLOTB);
  bf16x8 qr[4];
  #pragma unroll
  for(int d0=0;d0<4;++d0)qr[d0]=*reinterpret_cast<const bf16x8*>(&Qw[(long)r32*DM+d0*16+hi*8]);
  float mhat=0.f,l_reg=0.f;f32x16 o[2];o[0]=f32x16{};o[1]=f32x16{};f32x16 negm=f32x16{};asm volatile("":"+v"(negm));
  const int qpos=q0+wid*QBLK+r32;
  #define CMASK(P0,P1,t) do{ if((t)>=CTXT){ cmask(P0,P1,(TIX(t)-CTXT)*KVBLK-qpos+128,hi); } }while(0)
  bool resc=false;
  #define START(P0,P1) do{ const float rm=rowmax(P0,P1); resc=false; \
    { const float dl=rm; mhat=fadd_s(mhat,dl); \
      _Pragma("unroll") for(int r=0;r<16;++r){P0[r]=fsub_s(P0[r],dl);P1[r]=fsub_s(P1[r],dl);} \
      _Pragma("unroll") for(int r=0;r<16;++r)negm[r]=-mhat; asm volatile("":"+v"(negm)); } \
    _Pragma("unroll") for(int r=0;r<16;++r)P0[r]=__builtin_amdgcn_exp2f(P0[r]); }while(0)
  #define RESC() do{ if(resc){ asm volatile("s_waitcnt lgkmcnt(0)":::"memory"); \
      _Pragma("unroll") for(int d_=0;d_<2;++d_) _Pragma("unroll") for(int r=0;r<16;++r)o[d_][r]*=wsf[crow(r,hi)]; } }while(0)
  f32x16 pA0,pA1,pB0,pB1;
  int sl_prev=0,sl_cur=0,sl_next=SLOTB;
  #define ROT() do{sl_prev=sl_cur;sl_cur=sl_next;sl_next=(sl_next==(NSLOT-1)*SLOTB)?0:sl_next+SLOTB;}while(0)
  DMA_K(2,2*SLOTB);
  WAIT_BAR(3);
  qkt(pA0,pA1,Kbase,qr,negm,r32,hi);asm volatile("s_nop 15\n\ts_nop 7":"+v"(pA0),"+v"(pA1));CMASK(pA0,pA1,0);
  START(pA0,pA1);
  _Pragma("unroll") for(int r=0;r<16;++r)pA1[r]=__builtin_amdgcn_exp2f(pA1[r]);
  WAIT_BAR(0);
  DMA_K(3,0);DMA_V(1,SLOTB);
  ROT();
  kload8(kf,kp0+sl_cur);
  WAIT_BAR(2);
  s16x4 vlo[8],vhi[8]; u32x4 pw0,pw1,pw2,pw3;
  #define PKW(P,B) cvtpk_s(P[B],P[B+1])
  #define PAF(k) __builtin_bit_cast(bf16x8,pw##k)
  #define VFR(i) (bf16x8){vlo[i][0],vlo[i][1],vlo[i][2],vlo[i][3],vhi[i][0],vhi[i][1],vhi[i][2],vhi[i][3]}
  #define PIN(x) asm volatile("":"+v"(x))
  #define MX3(a,b,c) __builtin_fmaxf(__builtin_fmaxf((a),(b)),(c))
  #define GAPA(MF,A0,A1,A2,A3,W0,W1,PW) do{ MF; sacc+=A0; sacc+=A1; sacc+=A2; sacc+=A3; PIN(sacc); W0; W1; PIN(PW); SBAR(); }while(0)
  #define EX(v) __builtin_amdgcn_exp2f(v)
  #define GAPB(MF,X,B) do{ MF; X[B]=EX(X[B]); X[B+1]=EX(X[B+1]); X[B+2]=EX(X[B+2]); X[B+3]=EX(X[B+3]); PIN(X); SBAR(); }while(0)
  #define VRD(i) do{ vlo[i]=vtr(vp_+(((i)>>2)*4096+((i)&3)*1024)); vhi[i]=vtr(vp_+(((i)>>2)*4096+((i)&3)*1024+512)); }while(0)
  #define KRD(G,j) do{ if(G){ kload2(kf,kp0+sl_next,j); SBAR(); } }while(0)
  #define STEP(C0,C1,P0,P1,t,GK,GV,GL) do{ SBAR(); \
    const lds_cptr vp_=vp0+sl_prev; \
    VRD(0); SBAR(); float sacc=(P0[0]+P0[1]); \
    GAPA(C0=__builtin_amdgcn_mfma_f32_32x32x16_bf16(kf[0],qr[0],negm,0,0,0), P0[2],P0[3],P0[4],P0[5],     pw0[0]=PKW(P0,0), pw0[1]=PKW(P0,2), pw0); \
    VRD(4); SBAR(); GAPA(C1=__builtin_amdgcn_mfma_f32_32x32x16_bf16(kf[1],qr[0],negm,0,0,0), P0[6],P0[7],P0[8],P0[9],     pw0[2]=PKW(P0,4), pw0[3]=PKW(P0,6), pw0); \
    VRD(1); SBAR(); GAPA(C0=__builtin_amdgcn_mfma_f32_32x32x16_bf16(kf[2],qr[1],C0,0,0,0),   P0[10],P0[11],P0[12],P0[13], pw1[0]=PKW(P0,8), pw1[1]=PKW(P0,10), pw1); \
    VRD(5); SBAR(); GAPA(C1=__builtin_amdgcn_mfma_f32_32x32x16_bf16(kf[3],qr[1],C1,0,0,0),   P0[14],P0[15],P1[0],P1[1],   pw1[2]=PKW(P0,12),pw1[3]=PKW(P0,14), pw1); \
    VRD(2); SBAR(); GAPA(C0=__builtin_amdgcn_mfma_f32_32x32x16_bf16(kf[4],qr[2],C0,0,0,0),   P1[2],P1[3],P1[4],P1[5],     pw2[0]=PKW(P1,0), pw2[1]=PKW(P1,2), pw2); \
    VRD(6); SBAR(); GAPA(C1=__builtin_amdgcn_mfma_f32_32x32x16_bf16(kf[5],qr[2],C1,0,0,0),   P1[6],P1[7],P1[8],P1[9],     pw2[2]=PKW(P1,4), pw2[3]=PKW(P1,6), pw2); \
    VRD(3); SBAR(); GAPA(C0=__builtin_amdgcn_mfma_f32_32x32x16_bf16(kf[6],qr[3],C0,0,0,0),   P1[10],P1[11],P1[12],P1[13], pw3[0]=PKW(P1,8), pw3[1]=PKW(P1,10), pw3); \
    VRD(7); SBAR(); GAPA(C1=__builtin_amdgcn_mfma_f32_32x32x16_bf16(kf[7],qr[3],C1,0,0,0),   P1[14],P1[15],0.f,0.f,       pw3[2]=PKW(P1,12),pw3[3]=PKW(P1,14), pw3); \
    l_reg+=sacc; \
    if(GK){DMA_K((t)+3,sl_cur);} if(GV){DMA_V((t)+1,sl_next);} \
    CMASK(C0,C1,t); \
    { float a=MX3(C0[0],C0[1],C1[0]),b=MX3(C0[2],C0[3],C1[1]); a=MX3(a,C1[2],C1[3]); \
      _Pragma("unroll") for(int r=4;r<16;r+=4){a=MX3(a,C0[r],C0[r+1]);b=MX3(b,C0[r+2],C0[r+3]);a=MX3(a,C1[r],C1[r+1]);b=MX3(b,C1[r+2],C1[r+3]);} \
      float rm=__builtin_fmaxf(a,b); { auto rr=__builtin_amdgcn_permlane32_swap(__float_as_uint(rm),__float_as_uint(rm),false,false); rm=__builtin_fmaxf(__uint_as_float(rr[0]),__uint_as_float(rr[1])); } \
      resc=false; \
      if(__builtin_expect(__any(rm>(float)THRL),0)){ const float dl=__builtin_fmaxf(rm,0.f); mhat+=dl; \
        _Pragma("unroll") for(int r=0;r<16;++r){C0[r]-=dl;C1[r]-=dl;} \
        _Pragma("unroll") for(int r=0;r<16;++r)negm[r]=-mhat; asm volatile("":"+v"(negm)); \
        const float f=__builtin_amdgcn_exp2f(-dl); l_reg*=f; if(hi==0)wsf[r32]=f; resc=true; } } \
    SBAR(); \
    GAPB(o[0]=__builtin_amdgcn_mfma_f32_32x32x16_bf16(PAF(0),VFR(0),o[0],0,0,0), C0,0); \
    GAPB(o[1]=__builtin_amdgcn_mfma_f32_32x32x16_bf16(PAF(0),VFR(4),o[1],0,0,0), C0,4); \
    KRD(GL,0); GAPB(o[0]=__builtin_amdgcn_mfma_f32_32x32x16_bf16(PAF(1),VFR(1),o[0],0,0,0), C0,8); \
    KRD(GL,1); GAPB(o[1]=__builtin_amdgcn_mfma_f32_32x32x16_bf16(PAF(1),VFR(5),o[1],0,0,0), C0,12); \
    KRD(GL,2); GAPB(o[0]=__builtin_amdgcn_mfma_f32_32x32x16_bf16(PAF(2),VFR(2),o[0],0,0,0), C1,0); \
    KRD(GL,3); GAPB(o[1]=__builtin_amdgcn_mfma_f32_32x32x16_bf16(PAF(2),VFR(6),o[1],0,0,0), C1,4); \
    GAPB(o[0]=__builtin_amdgcn_mfma_f32_32x32x16_bf16(PAF(3),VFR(3),o[0],0,0,0), C1,8); \
    GAPB(o[1]=__builtin_amdgcn_mfma_f32_32x32x16_bf16(PAF(3),VFR(7),o[1],0,0,0), C1,12); \
    }while(0)
  int t=1;
  #undef CMASK
  #define CMASK(P0,P1,t) do{ if((t)>=CTXT){ cmask(P0,P1,(TIX(t)-CTXT)*KVBLK-qpos+128,hi); } }while(0)
  #define ENDW(tt) do{ if((tt)+3<NT){WAIT_BAR(2);} else if((tt)+2<NT){WAIT_BAR(1);} else {WAIT_BAR(0);} }while(0)
  for(;t+1<NT;t+=2){
    STEP(pB0,pB1,pA0,pA1,t,(t+3<NT),(t+1<NT),(t+1<NT));       ENDW(t);   RESC(); ROT();
    STEP(pA0,pA1,pB0,pB1,t+1,(t+4<NT),(t+2<NT),(t+2<NT));     ENDW(t+1); RESC(); ROT();
  }
  STEP(pB0,pB1,pA0,pA1,NT-1,false,false,false); RESC();
  { float sacc=pB0[0]+pB0[1]; _Pragma("unroll") for(int r=2;r<16;++r)sacc+=pB0[r]; _Pragma("unroll") for(int r=0;r<16;++r)sacc+=pB1[r]; l_reg+=sacc;
    pw0=(u32x4){PKW(pB0,0),PKW(pB0,2),PKW(pB0,4),PKW(pB0,6)};pw1=(u32x4){PKW(pB0,8),PKW(pB0,10),PKW(pB0,12),PKW(pB0,14)};pw2=(u32x4){PKW(pB1,0),PKW(pB1,2),PKW(pB1,4),PKW(pB1,6)};pw3=(u32x4){PKW(pB1,8),PKW(pB1,10),PKW(pB1,12),PKW(pB1,14)};
    SBAR(); pv(o,vb0+sl_cur,PAF(0),PAF(1),PAF(2),PAF(3)); }
  #undef PKW
  #undef PAF
  #undef VFR
  #undef PIN
  #undef MX3
  #undef GAPA
  #undef GAPB
  #undef EX
  #undef VRD
  #undef KRD
  #undef STEP
  #undef ENDW
  {auto rr=__builtin_amdgcn_permlane32_swap(__float_as_uint(l_reg),__float_as_uint(l_reg),false,false);l_reg=__uint_as_float(rr[0])+__uint_as_float(rr[1]);}
  l_reg+=__builtin_amdgcn_exp2f(sink[h]*1.4426950408889634f-mhat);
  if(hi==0)wsf[32+r32]=l_reg;asm volatile("s_waitcnt lgkmcnt(0)":::"memory");
  float rli[16];
  #pragma unroll
  for(int r=0;r<16;++r)rli[r]=__builtin_amdgcn_rcpf(wsf[32+crow(r,hi)]);
  bf16*Ow=O+(rowbase+q0+wid*QBLK)*DM+h*D;
  { bf16*stg=(bf16*)(shm+LDS_OST)+wid*2048;
    #pragma unroll
    for(int r=0;r<16;++r){const int orow=crow(r,hi);
      #pragma unroll
      for(int d0=0;d0<2;++d0)stg[orow*64+d0*32+r32]=__float2bfloat16(o[d0][r]*rli[r]);}
    asm volatile("s_waitcnt lgkmcnt(0)":::"memory");
    #pragma unroll
    for(int i=0;i<4;++i){const int row=i*8+(lane>>3),ch=lane&7; const u32x4 v=*(const u32x4*)(stg+row*64+ch*8); ATTN_STORE16(Ow+(long)row*DM+ch*8,v);} }
  asm volatile("s_waitcnt lgkmcnt(0)\n\ts_barrier":::"memory");
  #undef DMA_K
  #undef TIX
  #undef DMA_V
  #undef CMASK
  #undef START
  #undef RESC
  #undef ROT
}
constexpr int ATTN_LDS_BYTES=LDS_BYTES;
struct AttnTensors { const bf16* Q; const bf16* K; const bf16* V; bf16* O; const float* sink; };
struct AttnUnit { int bh; int qb; };
struct StaticOrder {
  int vcu;
  __device__ __forceinline__ explicit StaticOrder(int grid,int block):vcu((block%8)*(grid/8)+block/8){}
  __device__ __forceinline__ bool next(int i,AttnUnit&u)const{ if(i>=4)return false; const int s=vcu&7; u.bh=vcu>>3; u.qb=(i==0)?s:(i==1)?15-s:(i==2)?16+s:31-s; return true; }
  __device__ __forceinline__ void a_ready(const AttnUnit&)const{}
  __device__ __forceinline__ void done(const AttnUnit&)const{}
};
template<class Sched,int THRL=8> __device__ __forceinline__ void attn_phase(char*lds,const AttnTensors&T,const Sched&S){
  AttnUnit u;
  for(int i=0;S.next(i,u);++i){ S.a_ready(u); attn_unit<THRL>(u.bh/NHEAD,u.bh%NHEAD,u.qb,T.Q,T.K,T.V,T.O,T.sink,lds); S.done(u); }
}
#undef SBAR
#undef WAIT_BAR
}
#define GAS __attribute__((address_space(1)))
#define LAS __attribute__((address_space(3)))
typedef unsigned short bf16;
typedef unsigned v4u __attribute__((ext_vector_type(4)));
typedef float f32x4 __attribute__((ext_vector_type(4)));
typedef short bf16x8 __attribute__((ext_vector_type(8)));
typedef GAS unsigned gu32;
typedef GAS unsigned long long gu64;
#define RLX_AGENT __ATOMIC_RELAXED, __HIP_MEMORY_SCOPE_AGENT
#define LDS_WAIT() asm volatile("s_waitcnt lgkmcnt(0)" ::: "memory")
#define VM_WAIT() asm volatile("s_waitcnt vmcnt(0)" ::: "memory")
__device__ __forceinline__ unsigned long long rt() { return __builtin_amdgcn_s_memrealtime(); }
#define XB_TMO      128
#define XB_XCNT(j)  (256  + 64 * (j))
#define XB_XSUB(j)  (1280 + 64 * (j))
#define XB_XGEN(j)  (2304 + 64 * (j))
#define XB_TOP      3328
#define XB_TOPGEN   3392
#define XCD_BAR_WORDS 3456
#define XB_SPIN_CAP (1u << 18)

__device__ __forceinline__ unsigned xb_ld(unsigned* p)              { return __hip_atomic_load(p, __ATOMIC_RELAXED, __HIP_MEMORY_SCOPE_AGENT); }
__device__ __forceinline__ unsigned xb_add(unsigned* p, unsigned v) { return __hip_atomic_fetch_add(p, v, __ATOMIC_RELAXED, __HIP_MEMORY_SCOPE_AGENT); }
__device__ __forceinline__ unsigned xb_xcc_id() { return (unsigned)__builtin_amdgcn_s_getreg((3 << 11) | 20) & 0xFu; }
#define XB_SPIN(cond, bar) do { unsigned _sp = 0; while (cond) { __builtin_amdgcn_s_sleep(1); \
    if ((++_sp & 255u) == 0u) { if (xb_ld(&(bar)[XB_TMO])) break; if (_sp > XB_SPIN_CAP) { atomicAdd(&(bar)[XB_TMO], 1u); break; } } } } while (0)

struct XcdBarrier {
    unsigned* bar; unsigned x;
    volatile LAS unsigned* st;
};

__device__ __forceinline__ XcdBarrier xcd_barrier_post(unsigned* bar, volatile LAS unsigned* st) {
    XcdBarrier b; b.bar = bar; b.x = xb_xcc_id(); b.st = st;
    if (threadIdx.x == 0) (void)xb_add(&bar[XB_XCNT(b.x)], 1u);
    return b;
}
__device__ __forceinline__ void xcd_barrier_complete(unsigned* bar, unsigned x, unsigned& nloc, unsigned& nx) {
    const unsigned G = gridDim.x * gridDim.y * gridDim.z;
    unsigned sum, cnt, mine, sp = 0u;
    for (;;) {
        sum = 0u; cnt = 0u; mine = 0u;
#pragma unroll
        for (unsigned j = 0; j < 16; ++j) { const unsigned c = xb_ld(&bar[XB_XCNT(j)]); sum += c; cnt += (c > 0u) ? 1u : 0u; mine = (j == x) ? c : mine; }
        if (sum == G) break;
        __builtin_amdgcn_s_sleep(1);
        if ((++sp & 255u) == 0u) { if (xb_ld(&bar[XB_TMO])) break; if (sp > XB_SPIN_CAP) { atomicAdd(&bar[XB_TMO], 1u); break; } }
    }
    nloc = mine > 0u ? mine : 1u; nx = cnt > 0u ? cnt : 1u;
}

__device__ __forceinline__ void xcd_barrier(const XcdBarrier& b) {
    asm volatile("s_waitcnt vmcnt(0)" ::: "memory");
    __syncthreads();
    if (threadIdx.x == 0) {
        unsigned* bar = b.bar;
        __builtin_amdgcn_s_waitcnt(0);
        unsigned nloc = b.st[0], nx = b.st[1];
        if (nloc == 0u) { xcd_barrier_complete(bar, b.x, nloc, nx); b.st[0] = nloc; b.st[1] = nx; }
        const unsigned old = xb_add(&bar[XB_XSUB(b.x)], 1u);
        const unsigned gen = old / nloc;
        if (old + 1u == (gen + 1u) * nloc) {
            __builtin_amdgcn_fence(__ATOMIC_RELEASE, "agent");
            asm volatile("s_waitcnt vmcnt(0)" ::: "memory");
            const unsigned og = xb_add(&bar[XB_TOP], 1u);
            const unsigned tg = og / nx;
            if (og + 1u == (tg + 1u) * nx) xb_add(&bar[XB_TOPGEN], 1u);
            else XB_SPIN(xb_ld(&bar[XB_TOPGEN]) == tg, bar);
            __builtin_amdgcn_fence(__ATOMIC_ACQUIRE, "agent");
            xb_add(&bar[XB_XGEN(b.x)], 1u);
            asm volatile("s_waitcnt vmcnt(0)" ::: "memory");
        } else {
            XB_SPIN(xb_ld(&bar[XB_XGEN(b.x)]) == gen, bar);
            __builtin_amdgcn_fence(__ATOMIC_ACQUIRE, "agent");
            asm volatile("s_waitcnt vmcnt(0)" ::: "memory");
        }
    }
    __syncthreads();
}
constexpr int NWAVES = 8;
#ifndef MK_N_LAUNCHES
#define MK_N_LAUNCHES 1
#endif
constexpr int N_PHASES = 10;
constexpr int N_LAUNCHES = MK_N_LAUNCHES;

constexpr int BATCH = 2, SEQ = 8192, D = 1024, CTXL = 256, NEXP = 32, TOPK = 4, DFF = 1024, INW = 4608;
constexpr int M = BATCH * SEQ;
constexpr int MC = BATCH * CTXL;
constexpr float NORM_EPS = 1e-5f;

constexpr size_t MiB = 1u << 20;
constexpr size_t WS_CTL = 0, CTL_ZERO_BYTES = 1 * MiB;
constexpr size_t WS_MOD = 1 * MiB;
constexpr size_t WS_WIN = 2 * MiB, WS_WAB = 11 * MiB, WS_WPL = 13 * MiB, WS_WOUT = 15 * MiB;
constexpr size_t WS_XN = 18 * MiB;
constexpr size_t WS_Q = 52 * MiB, WS_KX = 84 * MiB, WS_VX = 93 * MiB;
constexpr size_t WS_U = 102 * MiB, WS_SA = 134 * MiB, WS_SP = 166 * MiB, WS_AO = 198 * MiB, WS_DIFF = 230 * MiB, WS_MRG = 262 * MiB, WS_H2 = 294 * MiB;
constexpr size_t WS_LIST = 326 * MiB, WS_GW = 328 * MiB;
constexpr size_t WS_WGU = 330 * MiB, WS_WD = 458 * MiB;
constexpr size_t WS_ACT = 522 * MiB, WS_Y2 = 666 * MiB, WS_END = 794 * MiB;
constexpr int CW_TMO = 0, CW_CODE = 1;
constexpr int CW_BAR = 4096;
constexpr int CW_GCNT = 16384;

constexpr int RING_OFF = 0, RING_BYTES = 131072;
constexpr int LDSCTL_OFF = RING_BYTES, MISC_OFF = LDSCTL_OFF + 320;
constexpr int XTRA_OFF = LDSCTL_OFF + 1024;
constexpr int LDS_BYTES = 147456;

__constant__ float ROPE_INVF[16] = {1.0f, 0.5623413324356079f, 0.3162277638912201f, 0.17782793939113617f, 0.10000000149011612f, 0.05623413249850273f, 0.03162277489900589f, 0.017782794311642647f,
    0.009999999776482582f, 0.005623413249850273f, 0.003162277629598975f, 0.0017782794311642647f, 0.0010000000474974513f, 0.000562341301701963f, 0.0003162277571391314f, 0.00017782794020604342f};

struct Frame {
    LAS unsigned char* lds;
    volatile LAS unsigned* MISC;
    gu32* ctl;
    int tid, lane, wave;
    int vcu, G;
    const float *x, *c, *ctx, *c_ctx, *w_ada, *b_ada, *n1g, *n2g, *w_in, *b_in, *sink, *w_pool, *pscale, *w_ab, *w_pb, *w_out, *w_router, *b_router, *w_gu, *b_gu, *w_down, *b_down, *final_g;
    float* out;
    float *modx, *modc, *ropec, *ropes, *GW;
    bf16 *Win_t, *Wab_t, *Wpl_t, *Wout_t, *Wgu_t, *Wd_t;
    bf16 *XN, *Q, *KX, *VX, *U, *SA, *SP, *AO, *DIFF, *MRG, *H2, *ACT, *Y2;
    int* LIST;
};

__device__ __forceinline__ float wave_sum(float v) {
#pragma unroll
    for (int o = 1; o < 64; o <<= 1) v += __shfl_xor(v, o);
    return v;
}
__device__ __forceinline__ float wave_max(float v) {
#pragma unroll
    for (int o = 1; o < 64; o <<= 1) v = fmaxf(v, __shfl_xor(v, o));
    return v;
}
__device__ __forceinline__ int wave_min_i(int v) {
#pragma unroll
    for (int o = 1; o < 64; o <<= 1) { const int t = __shfl_xor(v, o); v = t < v ? t : v; }
    return v;
}
__device__ __forceinline__ void p0_transpose_item(const float* W, int K, int N, bf16* WT, int k0, int n0, int drow0, LAS float* scr, int lane) {
#pragma unroll 8
    for (int i = 0; i < 32; ++i) { const int kk = 2 * i + (lane >> 5); scr[kk * 33 + (lane & 31)] = W[(size_t)(k0 + kk) * N + n0 + (lane & 31)]; }
    LDS_WAIT(); asm volatile("" ::: "memory");
    const int c = lane & 7;
#pragma unroll
    for (int j = 0; j < 4; ++j) { const int n = (lane >> 3) + 8 * j; const LAS float* s = scr + (8 * c) * 33 + n;
        v4u o; o.x = pk2(s[0 * 33], s[1 * 33]); o.y = pk2(s[2 * 33], s[3 * 33]); o.z = pk2(s[4 * 33], s[5 * 33]); o.w = pk2(s[6 * 33], s[7 * 33]);
        *(GAS v4u*)(WT + (size_t)(drow0 + n) * K + k0 + 8 * c) = o; }
    LDS_WAIT(); asm volatile("" ::: "memory");
}
__device__ __forceinline__ float fsilu(float v) { return v / (1.0f + __expf(-v)); }

__device__ __forceinline__ void p0_prologue(Frame& F) {
    const int gw = F.vcu * NWAVES + F.wave, NGW = F.G * NWAVES, lane = F.lane;
    for (int it = gw; it < 1536; it += NGW) {
        const int n0 = 4 * it; const bool wantc = n0 < 2048;
        f32x4 a0 = {0.f, 0.f, 0.f, 0.f}, a1 = a0, a2 = a0;
#pragma unroll 4
        for (int j = 0; j < 16; ++j) { const int k = lane + 64 * j;
            const f32x4 w = *(const GAS f32x4*)(F.w_ada + (size_t)k * 6144 + n0);
            a0 += fsilu(F.c[k]) * w; a1 += fsilu(F.c[1024 + k]) * w; a2 += fsilu(F.c_ctx[k]) * w; }
#pragma unroll
        for (int i = 0; i < 4; ++i) { a0[i] = wave_sum(a0[i]); a1[i] = wave_sum(a1[i]); a2[i] = wave_sum(a2[i]); }
        if (lane == 0) { const f32x4 bb = *(const f32x4*)(F.b_ada + n0);
            *(f32x4*)(F.modx + n0) = a0 + bb; *(f32x4*)(F.modx + 6144 + n0) = a1 + bb; if (wantc) *(f32x4*)(F.modc + n0) = a2 + bb; }
    }
    if (gw == NGW - 1) {
        for (int idx = lane; idx < 3072; idx += 64) {
            const int ti = idx >> 4, p = idx & 15; const float pos = (float)(ti < 128 ? ti : ti - 128);
            const float angf = pos * ROPE_INVF[p];
            const double a = (double)angf; const double n = __builtin_rint(a * 0.63661977236758134308); const double r = __builtin_fma(-n, 6.123233995736766e-17, __builtin_fma(-n, 1.5707963267948966, a));
            const double r2 = r * r;
            double sp = -7.6471637318198164759e-13; sp = sp * r2 + 1.6059043836821614599e-10; sp = sp * r2 - 2.5052108385441718775e-8; sp = sp * r2 + 2.7557319223985890653e-6; sp = sp * r2 - 1.9841269841269841270e-4; sp = sp * r2 + 8.3333333333333333333e-3; sp = sp * r2 - 1.6666666666666666667e-1; const double sn = r + r * r2 * sp;
            double cp = 4.7794773323873852974e-14; cp = cp * r2 - 1.1470745597729724714e-11; cp = cp * r2 + 2.0876756987868098979e-9; cp = cp * r2 - 2.7557319223985890653e-7; cp = cp * r2 + 2.4801587301587301587e-5; cp = cp * r2 - 1.3888888888888888889e-3; cp = cp * r2 + 4.1666666666666666667e-2; cp = cp * r2 - 0.5; const double cs = 1.0 + r2 * cp;
            const int q = ((int)n) & 3; double co, si;
            if (q == 0) { co = cs; si = sn; } else if (q == 1) { co = -sn; si = cs; } else if (q == 2) { co = -cs; si = -sn; } else { co = sn; si = -cs; }
            F.ropec[idx] = (float)co; F.ropes[idx] = (float)si;
        }
    }
    LAS float* scr = (LAS float*)(F.lds + RING_OFF + F.wave * 16384);
    constexpr int I_IN = 16 * 144, I_AB = 16 * 32, I_OUT = 16 * 32, I_GU = 32 * 16 * 64, I_D = 32 * 16 * 32;
    constexpr int NITEMS = I_IN + I_AB + I_OUT + I_GU + I_D;
    for (int it = gw; it < NITEMS; it += NGW) {
        int r = it;
        if (r < I_IN) { const int kb = r / 144, nb = r % 144; p0_transpose_item(F.w_in, 1024, INW, F.Win_t, 64 * kb, 32 * nb, 32 * nb, scr, lane); continue; } r -= I_IN;
        if (r < I_AB) { const int kb = r / 32, nb = r % 32; p0_transpose_item(F.w_ab, 1024, 1024, F.Wab_t, 64 * kb, 32 * nb, 32 * nb, scr, lane); continue; } r -= I_AB;
        if (r < I_OUT) { const int kb = r / 32, nb = r % 32; p0_transpose_item(F.w_out, 1024, 1024, F.Wout_t, 64 * kb, 32 * nb, 32 * nb, scr, lane); continue; } r -= I_OUT;
        if (r < I_GU) { const int e = r >> 10, rr = r & 1023, kb = rr >> 6, nb = rr & 63; const int n0 = 32 * nb;
            const int d0 = (n0 < 1024) ? (256 * (n0 >> 7) + (n0 & 127)) : (256 * ((n0 - 1024) >> 7) + 128 + ((n0 - 1024) & 127));
            p0_transpose_item(F.w_gu + (size_t)e * 1024 * 2048, 1024, 2048, F.Wgu_t + (size_t)e * 2048 * 1024, 64 * kb, n0, d0, scr, lane); continue; } r -= I_GU;
        { const int e = r >> 9, rr = r & 511, kb = rr >> 5, nb = rr & 31;
            p0_transpose_item(F.w_down + (size_t)e * 1024 * 1024, 1024, 1024, F.Wd_t + (size_t)e * 1024 * 1024, 64 * kb, 32 * nb, 32 * nb, scr, lane); }
    }
    for (int gt = F.vcu * (NWAVES * 64) + F.tid; gt < 1024 * 128; gt += F.G * NWAVES * 64) {
        const int n = gt & 1023, kg = __builtin_amdgcn_readfirstlane(gt >> 10), k0 = 8 * kg, g = k0 >> 8;
        const float* wp = F.w_pool + (size_t)k0 * 256;
        float a[8];
#pragma unroll
        for (int i = 0; i < 8; ++i) a[i] = 0.f;
#pragma unroll 4
        for (int j = 0; j < 256; ++j) { const float bsc = F.pscale[256 * g + j] * F.w_pb[(size_t)(256 * g + j) * 1024 + n];
#pragma unroll
            for (int i = 0; i < 8; ++i) a[i] += wp[i * 256 + j] * bsc; }
        v4u o; o.x = pk2(a[0], a[1]); o.y = pk2(a[2], a[3]); o.z = pk2(a[4], a[5]); o.w = pk2(a[6], a[7]);
        *(GAS v4u*)(F.Wpl_t + (size_t)n * 1024 + k0) = o;
    }
}
__device__ __forceinline__ void p1_norm_mod(Frame& F) {
    const int gw = F.vcu * NWAVES + F.wave, NGW = F.G * NWAVES, lane = F.lane;
    for (int m = gw; m < M + MC; m += NGW) {
        const float* xrow; const float *sh, *sc;
        if (m < M) { xrow = F.x + (size_t)m * D; sh = F.modx + (m >> 13) * 6144; sc = sh + 1024; }
        else { xrow = F.ctx + (size_t)(m - M) * D; sh = F.modc; sc = F.modc + 1024; }
        const GAS f32x4* xr = (const GAS f32x4*)xrow + lane;
        f32x4 v[4]; float s = 0.f;
#pragma unroll
        for (int j = 0; j < 4; ++j) { v[j] = xr[64 * j]; s += (v[j].x * v[j].x + v[j].y * v[j].y) + (v[j].z * v[j].z + v[j].w * v[j].w); }
        const float rstd = 1.0f / sqrtf(wave_sum(s) * (1.f / D) + NORM_EPS);
        GAS unsigned long long* o8 = (GAS unsigned long long*)(F.XN + (size_t)m * D) + lane;
#pragma unroll
        for (int j = 0; j < 4; ++j) { const int c0 = 4 * lane + 256 * j;
            const f32x4 g = *(const f32x4*)(F.n1g + c0), a = *(const f32x4*)(sc + c0), h = *(const f32x4*)(sh + c0);
            const f32x4 y = (v[j] * rstd) * g * (a + 1.0f) + h;
            o8[64 * j] = (unsigned long long)pk2(y.x, y.y) | ((unsigned long long)pk2(y.z, y.w) << 32); }
    }
}
__device__ __forceinline__ void p3_pool_diff(Frame& F) {
    for (int idx = F.vcu * (NWAVES * 64) + F.tid; idx < M * 128; idx += F.G * NWAVES * 64) {
        const int m = idx >> 7, cb = idx & 127, g = cb >> 5, half = 1 << g, l = m & (SEQ - 1);
        const int lo = (l - half) < 0 ? 0 : (l - half), hi = (l + half) > SEQ ? SEQ : (l + half);
        const bf16* base = F.U + (size_t)(m - l) * D + cb * 8;
        float s[8];
#pragma unroll
        for (int i = 0; i < 8; ++i) s[i] = 0.f;
        for (int j = lo; j < hi; ++j) { const v4u w = *(const GAS v4u*)(base + (size_t)j * D);
            s[0] += bflo(w.x); s[1] += bfhi(w.x); s[2] += bflo(w.y); s[3] += bfhi(w.y); s[4] += bflo(w.z); s[5] += bfhi(w.z); s[6] += bflo(w.w); s[7] += bfhi(w.w); }
        const v4u w = *(const GAS v4u*)(base + (size_t)l * D); const float inv = 1.0f / (float)(hi - lo);
        const float u0 = bflo(w.x), u1 = bfhi(w.x), u2 = bflo(w.y), u3 = bfhi(w.y), u4 = bflo(w.z), u5 = bfhi(w.z), u6 = bflo(w.w), u7 = bfhi(w.w);
        v4u o; o.x = pk2(s[0] * inv - u0, s[1] * inv - u1); o.y = pk2(s[2] * inv - u2, s[3] * inv - u3); o.z = pk2(s[4] * inv - u4, s[5] * inv - u5); o.w = pk2(s[6] * inv - u6, s[7] * inv - u7);
        *(GAS v4u*)(F.DIFF + (size_t)m * D + cb * 8) = o;
    }
}
__device__ __forceinline__ void p6_router(Frame& F) {
    LAS float* WR = (LAS float*)(F.lds + RING_OFF);
    volatile LAS int* CNTL = (volatile LAS int*)(F.lds + XTRA_OFF + 384); volatile LAS int* BASEL = CNTL + 32; volatile LAS int* ENT = CNTL + 64;
    const int tid = F.tid, lane = F.lane, wave = F.wave;
    for (int i = tid; i < 8192; i += NWAVES * 64) { const int k = i >> 3, e4 = (i & 7) * 4; const f32x4 w = *(const GAS f32x4*)(F.w_router + (size_t)k * 32 + e4);
        WR[(e4 + 0) * 1024 + k] = w.x; WR[(e4 + 1) * 1024 + k] = w.y; WR[(e4 + 2) * 1024 + k] = w.z; WR[(e4 + 3) * 1024 + k] = w.w; }
    const int myexp = lane >> 1; const float brt = F.b_router[myexp];
    for (int rb = F.vcu; rb < M / 64; rb += F.G) {
        if (tid < 32) CNTL[tid] = 0;
        __syncthreads();
        const int b = (rb * 64) >> 13;
        const float* sh = F.modx + b * 6144 + 3072; const float* sc = sh + 1024;
#pragma unroll 1
        for (int pr = 0; pr < 8; ++pr) {
            const int row = rb * 64 + wave * 8 + pr, rl = wave * 8 + pr;
            f32x4 h[4];
            {
                const GAS f32x4* xr = (const GAS f32x4*)(F.out + (size_t)row * D) + lane; float s = 0.f;
#pragma unroll
                for (int j = 0; j < 4; ++j) { h[j] = xr[64 * j]; s += (h[j].x * h[j].x + h[j].y * h[j].y) + (h[j].z * h[j].z + h[j].w * h[j].w); }
                const float rstd = 1.0f / sqrtf(wave_sum(s) * (1.f / D) + NORM_EPS);
                GAS unsigned long long* o8 = (GAS unsigned long long*)(F.H2 + (size_t)row * D) + lane;
#pragma unroll
                for (int j = 0; j < 4; ++j) { const int c0 = 4 * lane + 256 * j;
                    const f32x4 g = *(const f32x4*)(F.n2g + c0), a = *(const f32x4*)(sc + c0), hh = *(const f32x4*)(sh + c0);
                    h[j] = (h[j] * rstd) * g * (a + 1.0f) + hh;
                    o8[64 * j] = (unsigned long long)pk2(h[j].x, h[j].y) | ((unsigned long long)pk2(h[j].z, h[j].w) << 32); }
            }
            float acc[32];
#pragma unroll
            for (int e = 0; e < 32; ++e) {
                float a0 = 0.f;
#pragma unroll
                for (int j = 0; j < 4; ++j) { const f32x4 w = *(const LAS f32x4*)(WR + e * 1024 + 256 * j + 4 * lane);
                    a0 += (h[j].x * w.x + h[j].y * w.y) + (h[j].z * w.z + h[j].w * w.w); }
                acc[e] = a0;
            }
            {
                float v16[16], v8[8], v4[4], v2[2], v1;
                { const bool up = (lane & 32) != 0;
#pragma unroll
                  for (int e = 0; e < 16; ++e) { const float send = up ? acc[e] : acc[e + 16], mine = up ? acc[e + 16] : acc[e]; v16[e] = mine + __shfl_xor(send, 32); } }
                { const bool up = (lane & 16) != 0;
#pragma unroll
                  for (int e = 0; e < 8; ++e) { const float send = up ? v16[e] : v16[e + 8], mine = up ? v16[e + 8] : v16[e]; v8[e] = mine + __shfl_xor(send, 16); } }
                { const bool up = (lane & 8) != 0;
#pragma unroll
                  for (int e = 0; e < 4; ++e) { const float send = up ? v8[e] : v8[e + 4], mine = up ? v8[e + 4] : v8[e]; v4[e] = mine + __shfl_xor(send, 8); } }
                { const bool up = (lane & 4) != 0;
#pragma unroll
                  for (int e = 0; e < 2; ++e) { const float send = up ? v4[e] : v4[e + 2], mine = up ? v4[e + 2] : v4[e]; v2[e] = mine + __shfl_xor(send, 4); } }
                { const bool up = (lane & 2) != 0; const float send = up ? v2[0] : v2[1], mine = up ? v2[1] : v2[0]; v1 = mine + __shfl_xor(send, 2); }
                float logit = v1 + __shfl_xor(v1, 1) + brt;
                float tv[4]; int te[4];
#pragma unroll
                for (int k = 0; k < 4; ++k) { const float mx = wave_max(logit); const int ix = wave_min_i(logit == mx ? myexp : 99); tv[k] = mx; te[k] = ix; if (myexp == ix) logit = -INFINITY; }
                const float e1 = __expf(tv[1] - tv[0]), e2 = __expf(tv[2] - tv[0]), e3 = __expf(tv[3] - tv[0]); const float inv = 1.0f / (1.0f + e1 + e2 + e3);
                if (lane < 4) { const float wk = (lane == 0 ? 1.0f : lane == 1 ? e1 : lane == 2 ? e2 : e3) * inv; const int ek = lane == 0 ? te[0] : lane == 1 ? te[1] : lane == 2 ? te[2] : te[3];
                    F.GW[(size_t)row * 4 + lane] = wk;
                    const int ls = __hip_atomic_fetch_add((LAS int*)&CNTL[ek], 1, __ATOMIC_RELAXED, __HIP_MEMORY_SCOPE_WORKGROUP);
                    ENT[rl * 4 + lane] = (ek << 16) | ls; }
            }
        }
        __syncthreads();
        if (tid < 32) BASEL[tid] = (int)__hip_atomic_fetch_add(F.ctl + CW_GCNT + 64 * tid, (unsigned)CNTL[tid], __ATOMIC_RELAXED, __HIP_MEMORY_SCOPE_AGENT);
        __syncthreads();
        if (tid < 256) { const int en = ENT[tid], e = en >> 16, ls = en & 0xffff; F.LIST[e * 16384 + BASEL[e] + ls] = (rb * 64 + (tid >> 2)) * 4 + (tid & 3); }
        __syncthreads();
    }
}
__device__ __forceinline__ void moe_prefix(Frame& F) {
    volatile LAS int* PT = (volatile LAS int*)(F.lds + XTRA_OFF); volatile LAS int* CN = PT + 64;
    if (F.tid == 0) { int acc = 0; for (int e = 0; e < 32; ++e) { const int c = (int)__hip_atomic_load(F.ctl + CW_GCNT + 64 * e, RLX_AGENT); CN[e] = c; PT[e] = acc; acc += (c + 255) >> 8; } PT[32] = acc; }
    __syncthreads();
}
__device__ __forceinline__ void p9_final(Frame& F) {
    const int gw = F.vcu * NWAVES + F.wave, NGW = F.G * NWAVES, lane = F.lane;
    for (int m = gw; m < M; m += NGW) {
        const float* g2 = F.modx + (m >> 13) * 6144 + 5120;
        GAS f32x4* xr = (GAS f32x4*)(F.out + (size_t)m * D) + lane;
        const f32x4 gwv = *(const f32x4*)(F.GW + (size_t)m * 4);
        f32x4 v[4]; float s = 0.f;
#pragma unroll
        for (int j = 0; j < 4; ++j) {
            f32x4 y = {0.f, 0.f, 0.f, 0.f};
#pragma unroll
            for (int k = 0; k < 4; ++k) { const unsigned long long w = *((const GAS unsigned long long*)(F.Y2 + ((size_t)m * 4 + k) * D) + lane + 64 * j); const unsigned wl = (unsigned)w, wh = (unsigned)(w >> 32);
                const float gk = gwv[k]; y.x += gk * bflo(wl); y.y += gk * bfhi(wl); y.z += gk * bflo(wh); y.w += gk * bfhi(wh); }
            const f32x4 g = *(const f32x4*)(g2 + 4 * lane + 256 * j);
            v[j] = xr[64 * j] + g * y; s += (v[j].x * v[j].x + v[j].y * v[j].y) + (v[j].z * v[j].z + v[j].w * v[j].w);
        }
        const float rstd = 1.0f / sqrtf(wave_sum(s) * (1.f / D) + NORM_EPS);
#pragma unroll
        for (int j = 0; j < 4; ++j) { const f32x4 g = *(const f32x4*)(F.final_g + 4 * lane + 256 * j); xr[64 * j] = (v[j] * rstd) * g; }
    }
}

struct Args { const float* in[23]; float* out; unsigned char* ws; int ph_lo, ph_hi; };
__global__ void __launch_bounds__(NWAVES * 64, 2) fwd_megakernel(Args args) {
    extern __shared__ __attribute__((aligned(16))) unsigned char lds[];
    Frame F;
    F.lds = (LAS unsigned char*)lds;
    F.MISC = (volatile LAS unsigned*)(F.lds + MISC_OFF);
    F.tid = threadIdx.x; F.lane = F.tid & 63; F.wave = __builtin_amdgcn_readfirstlane(F.tid >> 6);
    F.G = gridDim.x; { const int bx = blockIdx.x; F.vcu = (F.G % 8 == 0) ? (bx % 8) * (F.G / 8) + bx / 8 : bx; }
    unsigned char* ws = args.ws;
    F.ctl = (gu32*)(ws + WS_CTL);
    F.x = args.in[0]; F.c = args.in[1]; F.ctx = args.in[2]; F.c_ctx = args.in[3]; F.w_ada = args.in[4]; F.b_ada = args.in[5]; F.n1g = args.in[6]; F.n2g = args.in[7];
    F.w_in = args.in[8]; F.b_in = args.in[9]; F.sink = args.in[10]; F.w_pool = args.in[11]; F.pscale = args.in[12]; F.w_ab = args.in[13]; F.w_pb = args.in[14]; F.w_out = args.in[15];
    F.w_router = args.in[16]; F.b_router = args.in[17]; F.w_gu = args.in[18]; F.b_gu = args.in[19]; F.w_down = args.in[20]; F.b_down = args.in[21]; F.final_g = args.in[22];
    F.out = args.out;
    F.modx = (float*)(ws + WS_MOD); F.modc = (float*)(ws + WS_MOD + 49152); F.ropec = (float*)(ws + WS_MOD + 65536); F.ropes = (float*)(ws + WS_MOD + 77824); F.GW = (float*)(ws + WS_GW);
    F.Win_t = (bf16*)(ws + WS_WIN); F.Wab_t = (bf16*)(ws + WS_WAB); F.Wpl_t = (bf16*)(ws + WS_WPL); F.Wout_t = (bf16*)(ws + WS_WOUT); F.Wgu_t = (bf16*)(ws + WS_WGU); F.Wd_t = (bf16*)(ws + WS_WD);
    F.XN = (bf16*)(ws + WS_XN); F.Q = (bf16*)(ws + WS_Q); F.KX = (bf16*)(ws + WS_KX); F.VX = (bf16*)(ws + WS_VX); F.U = (bf16*)(ws + WS_U); F.SA = (bf16*)(ws + WS_SA); F.SP = (bf16*)(ws + WS_SP);
    F.AO = (bf16*)(ws + WS_AO); F.DIFF = (bf16*)(ws + WS_DIFF); F.MRG = (bf16*)(ws + WS_MRG); F.H2 = (bf16*)(ws + WS_H2); F.ACT = (bf16*)(ws + WS_ACT); F.Y2 = (bf16*)(ws + WS_Y2);
    F.LIST = (int*)(ws + WS_LIST);
    for (int u = F.tid; u < (LDS_BYTES - LDSCTL_OFF) / 4; u += NWAVES * 64) ((LAS unsigned*)(F.lds + LDSCTL_OFF))[u] = 0u;
    __syncthreads();
    XcdBarrier bar; bar.bar = (unsigned*)(F.ctl + CW_BAR); bar.x = 0; bar.st = nullptr;
    if (N_LAUNCHES == 1) bar = xcd_barrier_post((unsigned*)(F.ctl + CW_BAR), F.MISC + 8);
#define GRID_BAR() do { if (N_LAUNCHES == 1) { xcd_barrier(bar); } } while (0)
    const int lo = args.ph_lo, hi = args.ph_hi;
#ifndef PH_MASK
#define PH_MASK 0x3ff
#endif
#define IN(k) (((PH_MASK >> (k)) & 1) && lo <= (k) && (k) < hi)
#define BOTH(k) (IN(k) && IN((k) + 1))
    using namespace pg8;
    if (IN(0)) { p0_prologue(F); if (BOTH(0)) GRID_BAR(); }
    if (IN(1)) { p1_norm_mod(F); if (BOTH(1)) GRID_BAR(); }
    if (IN(2)) {
        OrdInProj S{F.G, (int)blockIdx.x, (const char*)F.XN, (const char*)F.Win_t};
        EpiInProj E{F.b_in, F.Q, F.KX, F.U, (WS_VX - WS_KX) / 2, (WS_SA - WS_U) / 2, F.ropec, F.ropes};
        static_assert(WS_SP - WS_SA == WS_SA - WS_U, "U | SA | SP equally spaced");
        gemm_phase<EpiInProj, OrdInProj, true, false>(F.lds + RING_OFF, 1024, 1024, S, E);
        if (BOTH(2)) GRID_BAR();
    }
    if (IN(3)) {
        const attn_body::AttnTensors AT{(const attn_body::bf16*)F.Q, (const attn_body::bf16*)F.KX, (const attn_body::bf16*)F.VX, (attn_body::bf16*)F.AO, F.sink};
        const attn_body::StaticOrder S((int)F.G, (int)blockIdx.x);
        attn_body::attn_phase<attn_body::StaticOrder>((char*)lds + RING_OFF, AT, S);
        p3_pool_diff(F);
        if (BOTH(3)) GRID_BAR();
    }
    if (IN(4)) {
        OrdMerge S{F.G, (int)blockIdx.x, (const char*)F.AO, (const char*)F.DIFF, (const char*)F.Wab_t, (const char*)F.Wpl_t};
        EpiMerge E{F.SA, F.SP, F.MRG};
        gemm_phase<EpiMerge, OrdMerge, true, false>(F.lds + RING_OFF, 1024, 1024, S, E);
        if (BOTH(4)) GRID_BAR();
    }
    if (IN(5)) {
        OrdStatic S; S.init(M, D, F.G, (int)blockIdx.x, F.MRG, F.Wout_t);
        EpiOut E{F.x, F.modx, F.out};
        gemm_phase<EpiOut, OrdStatic, true, false>(F.lds + RING_OFF, 1024, 1024, S, E);
        if (BOTH(5)) GRID_BAR();
    }
    if (IN(6)) { p6_router(F); if (BOTH(6)) GRID_BAR(); }
    if (IN(7)) {
        moe_prefix(F);
        volatile LAS int* PT = (volatile LAS int*)(F.lds + XTRA_OFF);
        OrdMoe S{F.G, (int)blockIdx.x, 8, PT, PT + 64, (const char*)F.H2, (const char*)F.Wgu_t, (size_t)2048 * 1024 * 2, F.LIST, 1};
        EpiSwiglu E{F.b_gu, F.ACT};
        gemm_phase<EpiSwiglu, OrdMoe, true, true>(F.lds + RING_OFF, 1024, 1024, S, E);
        if (BOTH(7)) GRID_BAR();
    }
    if (IN(8)) {
        moe_prefix(F);
        volatile LAS int* PT = (volatile LAS int*)(F.lds + XTRA_OFF);
        OrdMoe S{F.G, (int)blockIdx.x, 4, PT, PT + 64, (const char*)F.ACT, (const char*)F.Wd_t, (size_t)1024 * 1024 * 2, F.LIST, 0};
        EpiDown E{F.b_down, F.Y2, F.LIST, PT + 64};
        gemm_phase<EpiDown, OrdMoe, true, false>(F.lds + RING_OFF, 1024, 1024, S, E);
        if (BOTH(8)) GRID_BAR();
    }
    if (IN(9)) { p9_final(F); }
#undef IN
#undef BOTH
#undef GRID_BAR
}

extern "C" void kernel_launch(void* const* d_in, const int* in_sizes, int n_in, void* d_out, int out_size, void* d_ws, size_t ws_size, hipStream_t stream) {
    static int grid = 0;
    if (grid == 0) {
        if (n_in != 23 || in_sizes[0] != M * D || out_size != M * D || ws_size < WS_END) { fprintf(stderr, "kernel_launch: built for 23 inputs, x/out of %d floats, >= %zu bytes of workspace; got n_in %d, in0 %d, out %d, ws %zu; nothing launched\n", M * D, (size_t)WS_END, n_in, n_in > 0 ? in_sizes[0] : -1, out_size, ws_size); grid = -1; return; }
        int dev = 0, cus = 0, per_cu = 0;
        if (hipGetDevice(&dev) != hipSuccess || hipDeviceGetAttribute(&cus, hipDeviceAttributeMultiprocessorCount, dev) != hipSuccess) { fprintf(stderr, "kernel_launch: hipGetDevice / hipDeviceGetAttribute failed\n"); grid = -1; return; }
        if (hipFuncSetAttribute((const void*)fwd_megakernel, hipFuncAttributeMaxDynamicSharedMemorySize, LDS_BYTES) != hipSuccess) { fprintf(stderr, "kernel_launch: hipFuncSetAttribute failed\n"); grid = -1; return; }
        if (hipOccupancyMaxActiveBlocksPerMultiprocessor(&per_cu, (const void*)fwd_megakernel, NWAVES * 64, LDS_BYTES) != hipSuccess || per_cu < 1) { fprintf(stderr, "kernel_launch: occupancy query reports %d workgroups per CU; nothing launched\n", per_cu); (void)hipGetLastError(); grid = -1; return; }
        grid = cus;
        if (grid > 256) grid = 256;
    }
    if (grid < 0) return;
    if (hipMemsetAsync((char*)d_ws + WS_CTL, 0, CTL_ZERO_BYTES, stream) != hipSuccess) { fprintf(stderr, "kernel_launch: hipMemsetAsync failed\n"); return; }
    Args a{};
    for (int i = 0; i < 23; ++i) a.in[i] = (const float*)d_in[i];
    a.out = (float*)d_out; a.ws = (unsigned char*)d_ws;
    for (int li = 0; li < N_LAUNCHES; ++li) {
        a.ph_lo = (N_LAUNCHES == 1) ? 0 : li; a.ph_hi = (N_LAUNCHES == 1) ? N_PHASES : li + 1;
        hipLaunchKernelGGL(fwd_megakernel, dim3(grid), dim3(NWAVES * 64), LDS_BYTES, stream, a);
        const hipError_t le = hipPeekAtLastError();
        if (le != hipSuccess) { fprintf(stderr, "kernel_launch: launch %d failed: %s\n", li, hipGetErrorName(le)); break; }
    }
}
```

```cpp
#include <hip/hip_runtime.h>
#include <hip/hip_bf16.h>
#include <cstdio>
#include <cstdint>
#include <cmath>

typedef float f32x2_t __attribute__((ext_vector_type(2))); typedef __bf16 bf16x2_t __attribute__((ext_vector_type(2)));
__device__ __forceinline__ unsigned pk2(float lo, float hi) { f32x2_t v = {lo, hi}; bf16x2_t b = __builtin_convertvector(v, bf16x2_t); return __builtin_bit_cast(unsigned, b); }
__device__ __forceinline__ float bflo(unsigned w) { return __uint_as_float(w << 16); }
__device__ __forceinline__ float bfhi(unsigned w) { return __uint_as_float(w & 0xffff0000u); }
__device__ __forceinline__ float fsigmoid(float x) { return __builtin_amdgcn_rcpf(1.0f + __builtin_amdgcn_exp2f(-1.4426950408889634f * x)); }
__device__ __forceinline__ unsigned pk4_fp8(float a, float b, float c, float d) { int w = 0; w = __builtin_amdgcn_cvt_pk_fp8_f32(a, b, w, false); w = __builtin_amdgcn_cvt_pk_fp8_f32(c, d, w, true); return (unsigned)w; }
constexpr float MOE_WSCALE = 64.0f, MOE_ASCALE = 4.0f, Y2_SCALE = 8.0f, MRG_SCALE = 8.0f;
constexpr float ATT_C2 = 0.125f * 1.4426950408889634f;

namespace pg8 {
#define PG8_LAS __attribute__((address_space(3)))
typedef unsigned short bf16_t;
typedef short bf16x8 __attribute__((ext_vector_type(8)));
typedef float f32x4 __attribute__((ext_vector_type(4)));
typedef unsigned u32x4 __attribute__((ext_vector_type(4)));
typedef unsigned u32x2 __attribute__((ext_vector_type(2)));
typedef int i32x4v __attribute__((ext_vector_type(4)));
constexpr int PARK_OFF = 131072 + 1024 + 4096;
constexpr int BM = 256, BK = 64, HALF = 128, HTB = HALF * BK * 2  , STAGE_BYTES = 8 * HTB, NXCD = 8, WGM = 8;

__host__ __device__ __forceinline__ int lds_byte(int r, int c) { return r * 128 + ((((c >> 3) ^ (r >> 1)) & 7) << 4); }
__host__ __device__ __forceinline__ void stage_rc(int b, int& R, int& C) { const int s = b >> 4; R = s >> 3; C = (((s & 7) ^ (R >> 1)) & 7) << 3; }
__host__ __device__ __forceinline__ int perm32(int rho) { const int n = rho >> 4, i = rho & 15; return 8 * (i >> 2) + 4 * n + (i & 3); }

struct Unit { int pm, pn; const char* a; const char* b; int x0, x1; int rot = 0; };

__host__ __device__ __forceinline__ int xcd_remap(int wgid, int nwg) { const int q = nwg / NXCD, r = nwg % NXCD, xcd = wgid % NXCD, off = wgid / NXCD; return (xcd < r ? xcd * (q + 1) : r * (q + 1) + (xcd - r) * q) + off; }
__host__ __device__ __forceinline__ void tile_map(int wgid, int nM, int nN, int& pm, int& pn) {
    const int nig = WGM * nN, gid = wgid / nig, fm = gid * WGM, gsz = (nM - fm) < WGM ? (nM - fm) : WGM;
    pm = fm + ((wgid % nig) % gsz); pn = (wgid % nig) / gsz;
}

typedef int i32x8 __attribute__((ext_vector_type(8)));
__device__ __forceinline__ void glds_sv(const char* sbase, unsigned voff, unsigned lds_dst) { unsigned keep;
    asm volatile("s_mov_b32 %0, m0\n\ts_mov_b32 m0, %3\n\ts_nop 0\n\tglobal_load_lds_dwordx4 %1, %2\n\ts_mov_b32 m0, %0" : "=&s"(keep) : "v"(voff), "s"(sbase), "s"(lds_dst) : "memory"); }
__device__ __forceinline__ void glds_sv4(const char* sbase, unsigned voff, unsigned lds_dst) { unsigned keep;
    asm volatile("s_mov_b32 %0, m0\n\ts_mov_b32 m0, %3\n\ts_nop 0\n\tglobal_load_lds_dword %1, %2\n\ts_mov_b32 m0, %0" : "=&s"(keep) : "v"(voff), "s"(sbase), "s"(lds_dst) : "memory"); }
template <int N> __device__ __forceinline__ void wait_vm() { static_assert(N >= 0 && N < 64, "vmcnt is a 6-bit count"); asm volatile("s_waitcnt vmcnt(%0)" :: "n"(N) : "memory"); }
__device__ __forceinline__ int fresh_lane() { int l; asm volatile("v_mbcnt_lo_u32_b32 %0, -1, 0\n\tv_mbcnt_hi_u32_b32 %0, -1, %0" : "=v"(l)); return l; }
template <class Epi, class Sched, bool ALIGN_EPI, bool GATHER, int ES = 2>
__device__ __forceinline__ void gemm_phase(PG8_LAS unsigned char* lds, const int K, const int lda, const Sched& S, const Epi& E) {
    const int tid = threadIdx.x, wid = __builtin_amdgcn_readfirstlane(tid >> 6), lane = tid & 63, wr = wid >> 2, wc = wid & 3, fr = lane & 15, fq = lane >> 4;
    const int nt = (K * ES) / (BK * 2);
    unsigned voffB[2];
#pragma unroll
    for (int i = 0; i < 2; ++i) { int R, C; stage_rc(tid * 16 + i * 8192, R, C); const int Rb = Epi::PERM ? ((R & ~31) + perm32(R & 31)) : R;
        voffB[i] = (unsigned)(Rb * K * ES + C * 2); }
    const size_t kstep = (size_t)(BK * 2);
    const size_t hstepB = (size_t)HALF * K * ES;
    const unsigned ldsb = (unsigned)__builtin_amdgcn_readfirstlane((int)((unsigned)(uintptr_t)lds + (unsigned)wid * 1024u));
    const int aoff = lds_byte(wr * 64 + fr, fq * 8), boff = lds_byte(wc * 32 + fr, fq * 8), aoff1 = lds_byte(wr * 64 + fr, 32 + fq * 8), boff1 = lds_byte(wc * 32 + fr, 32 + fq * 8);
#define PG8_SA(b, h) (((b) * 2 + (h)) * HTB)
#define PG8_SB(b, h) ((4 + (b) * 2 + (h)) * HTB)
#define PG8_STAGE(bufoff, gbase, v0, v1) do { glds_sv((const char*)(gbase), (v0), ldsb + (unsigned)(bufoff)); glds_sv((const char*)(gbase), (v1), ldsb + (unsigned)(bufoff) + 8192u); } while (0)
#define PG8_LD8(dst8, off0_, off1_) do { const i32x4v lo_ = *(const PG8_LAS i32x4v*)(lds + (off0_)); const i32x4v hi_ = *(const PG8_LAS i32x4v*)(lds + (off1_)); dst8 = __builtin_shufflevector(lo_, hi_, 0, 1, 2, 3, 4, 5, 6, 7); } while (0)
#define PG8_LDA(dst, b, h) do { _Pragma("unroll") for (int m = 0; m < 4; ++m) { if constexpr (ES == 2) { dst[m][0] = *(const PG8_LAS bf16x8*)(lds + PG8_SA(b, h) + aoff + m * 2048); dst[m][1] = *(const PG8_LAS bf16x8*)(lds + PG8_SA(b, h) + aoff1 + m * 2048); } \
        else { PG8_LD8(dst##8[m], PG8_SA(b, h) + aoff + m * 2048, PG8_SA(b, h) + aoff1 + m * 2048); } } } while (0)
#define PG8_LDB(dst, b, h) do { _Pragma("unroll") for (int n = 0; n < 2; ++n) { if constexpr (ES == 2) { dst[n][0] = *(const PG8_LAS bf16x8*)(lds + PG8_SB(b, h) + boff + n * 2048); dst[n][1] = *(const PG8_LAS bf16x8*)(lds + PG8_SB(b, h) + boff1 + n * 2048); } \
        else { PG8_LD8(dst##8[n], PG8_SB(b, h) + boff + n * 2048, PG8_SB(b, h) + boff1 + n * 2048); } } } while (0)
#define PG8_MMA(ai, bj, At, Bt) do { __builtin_amdgcn_s_setprio(1); _Pragma("unroll") for (int m = 0; m < 4; ++m) _Pragma("unroll") for (int n = 0; n < 2; ++n) { \
        if constexpr (ES == 2) { _Pragma("unroll") for (int k = 0; k < 2; ++k) acc[ai][bj][m][n] = __builtin_amdgcn_mfma_f32_16x16x32_bf16(Bt[n][k], At[m][k], acc[ai][bj][m][n], 0, 0, 0); } \
        else { asm("v_mfma_scale_f32_16x16x128_f8f6f4 %0, %1, %2, %0, %3, %3 op_sel_hi:[0,0,0]" : "+v"(acc[ai][bj][m][n]) : "v"(Bt##8[n]), "v"(At##8[m]), "v"(one_scale)); PG8_MMA_PROBE(ai, bj, m, n, At, Bt) } } \
        __builtin_amdgcn_s_setprio(0); } while (0)
#ifdef MMA_REP
#define PG8_MMA_PROBE(ai, bj, m, n, At, Bt) if constexpr (MMA_REP == 0 || MMA_REP == Epi::NSTORES) asm("v_mfma_scale_f32_16x16x128_f8f6f4 %0, %1, %2, %0, %3, %3 op_sel_hi:[0,0,0]" : "+v"(acc[ai][bj][m][n]) : "v"(Bt##8[n]), "v"(At##8[m]), "v"(zero_scale));
#else
#define PG8_MMA_PROBE(ai, bj, m, n, At, Bt)
#endif
#define PG8_WAIT_V(n) asm volatile("s_waitcnt vmcnt(" #n ")" ::: "memory")
#define PG8_WAIT_L(n) asm volatile("s_waitcnt lgkmcnt(" #n ")" ::: "memory")
#define PG8_BAR __builtin_amdgcn_s_barrier()
#define PG8_SCHED __builtin_amdgcn_sched_barrier(0)
#define PG8_AVOFF(dst, u) do { const int tid_ = wid * 64 + fresh_lane(); _Pragma("unroll") for (int h_ = 0; h_ < 2; ++h_) _Pragma("unroll") for (int i_ = 0; i_ < 2; ++i_) { int R_, C_; stage_rc(tid_ * 16 + i_ * 8192, R_, C_); \
        const unsigned row_ = GATHER ? S.a_row((u), h_ * HALF + R_) : (unsigned)(h_ * HALF + R_); dst[h_][i_] = row_ * (unsigned)(lda * ES) + (unsigned)C_ * 2u; } } while (0)
#define PG8_NVOFF(dst) do { const int l_ = fresh_lane(); const int tid_ = wid * 64 + l_; _Pragma("unroll") for (int h_ = 0; h_ < 2; ++h_) _Pragma("unroll") for (int i_ = 0; i_ < 2; ++i_) { int R_, C_; stage_rc(tid_ * 16 + i_ * 8192, R_, C_); \
        const unsigned ent_ = *(const PG8_LAS unsigned*)(lds + PARK_OFF + wid * 1024 + (h_ * 2 + i_) * 256 + l_ * 4); const unsigned row_ = S.row_of(nxt, h_ * HALF + R_, ent_); dst[h_][i_] = row_ * (unsigned)(lda * ES) + (unsigned)C_ * 2u; } } while (0)
    const unsigned parkb = (unsigned)__builtin_amdgcn_readfirstlane((int)((unsigned)(uintptr_t)lds + (unsigned)PARK_OFF + (unsigned)wid * 1024u));
    Unit cur, nxt; int ui = 0;
    if (!S.next(0, cur)) return;
    f32x4 acc[2][2][4][2];
#pragma unroll
    for (int a = 0; a < 2; ++a)
#pragma unroll
        for (int b = 0; b < 2; ++b)
#pragma unroll
            for (int m = 0; m < 4; ++m)
#pragma unroll
                for (int n = 0; n < 2; ++n) acc[a][b][m][n] = (f32x4){0.f, 0.f, 0.f, 0.f};
    bf16x8 At[4][2], B0[2][2], B1[2][2]; i32x8 At8[4], B08[2], B18[2];
    unsigned vA[2][2];
    const unsigned zero_scale = 0u; (void)zero_scale;
    const unsigned one_scale = 0x7F7F7F7Fu;
    PG8_AVOFF(vA, cur);
    const int ntm = nt - 1;
#define PG8_KT(x, r) ((size_t)(((x) + (r)) & ntm) * kstep)
    const char* cA = cur.a; const char* cB = cur.b; int rot = cur.rot;
    { const size_t k0 = PG8_KT(0, rot); PG8_STAGE(PG8_SB(0, 0), cB + k0, voffB[0], voffB[1]); PG8_STAGE(PG8_SB(0, 1), cB + hstepB + k0, voffB[0], voffB[1]); PG8_STAGE(PG8_SA(0, 0), cA + k0, vA[0][0], vA[0][1]); PG8_STAGE(PG8_SA(0, 1), cA + k0, vA[1][0], vA[1][1]); }
    if (wr == 1) PG8_BAR;
    PG8_WAIT_V(2); PG8_BAR;
    { const size_t k1 = PG8_KT(1, rot); PG8_STAGE(PG8_SB(1, 0), cB + k1, voffB[0], voffB[1]); PG8_STAGE(PG8_SA(1, 0), cA + k1, vA[0][0], vA[0][1]); PG8_STAGE(PG8_SB(1, 1), cB + hstepB + k1, voffB[0], voffB[1]); }
    PG8_WAIT_V(6); PG8_BAR;
    for (;;) {
        const bool has_next = S.next(ui + 1, nxt);
        typename Epi::Pre pre; E.prefetch(pre, cur, wr, wc, fresh_lane());
        const char* nA = has_next ? nxt.a : cA; const char* nB = has_next ? nxt.b : cB; const int nrot = has_next ? nxt.rot : rot;
        if (GATHER && has_next) {
            const int tid_ = wid * 64 + fresh_lane();
#pragma unroll
            for (int h_ = 0; h_ < 2; ++h_)
#pragma unroll
                for (int i_ = 0; i_ < 2; ++i_) { int R_, C_; stage_rc(tid_ * 16 + i_ * 8192, R_, C_);
                    glds_sv4(S.list_base(nxt), (unsigned)(h_ * HALF + R_) * 4u, parkb + (unsigned)(h_ * 2 + i_) * 256u); }
        }
#pragma unroll 1
        for (int t = 0; t < nt; t += 2) {
            const bool last = (t == nt - 2);
            const char* a1 = cA + PG8_KT(t + 1, rot);
            const size_t k2 = last ? PG8_KT(0, nrot) : PG8_KT(t + 2, rot); const char* a2 = (last ? nA : cA) + k2; const char* b2 = (last ? nB : cB) + k2;
            const char* a3 = a2 + kstep; const char* b3 = b2 + kstep;
            unsigned s00, s01, s10, s11;
            if (GATHER) { if (last && has_next) { unsigned t_[2][2]; PG8_NVOFF(t_); s00 = t_[0][0]; s01 = t_[0][1]; s10 = t_[1][0]; s11 = t_[1][1]; } else { s00 = vA[0][0]; s01 = vA[0][1]; s10 = vA[1][0]; s11 = vA[1][1]; } }
            else { s00 = vA[0][0]; s01 = vA[0][1]; s10 = vA[1][0]; s11 = vA[1][1]; }
            const bool relax = Epi::NSTORES > 0 && t == 0 && ui > 0;
            PG8_LDB(B0, 0, 0); PG8_LDB(B1, 0, 1); PG8_SCHED; PG8_LDA(At, 0, 0); PG8_STAGE(PG8_SA(1, 1), a1, vA[1][0], vA[1][1]);
            if (relax) { wait_vm<8 + Epi::NSTORES>(); } else { PG8_WAIT_V(8); } PG8_WAIT_L(0); PG8_BAR; PG8_MMA(0, 0, At, B0); PG8_MMA(0, 1, At, B1); PG8_BAR; PG8_SCHED;
            PG8_LDA(At, 0, 1); PG8_STAGE(PG8_SB(0, 0), b2, voffB[0], voffB[1]); PG8_STAGE(PG8_SB(0, 1), b2 + hstepB, voffB[0], voffB[1]); PG8_STAGE(PG8_SA(0, 0), a2, s00, s01);
            if (relax) { wait_vm<8 + Epi::NSTORES>(); } else { PG8_WAIT_V(8); } PG8_WAIT_L(0); PG8_BAR; PG8_MMA(1, 0, At, B0); PG8_MMA(1, 1, At, B1); PG8_BAR; PG8_SCHED;
            PG8_LDB(B0, 1, 0); PG8_LDB(B1, 1, 1); PG8_SCHED; PG8_LDA(At, 1, 0); PG8_STAGE(PG8_SA(0, 1), a2, s10, s11);
            PG8_WAIT_V(8); PG8_WAIT_L(0); PG8_BAR; PG8_MMA(0, 0, At, B0); PG8_MMA(0, 1, At, B1); PG8_BAR; PG8_SCHED;
            PG8_LDA(At, 1, 1); PG8_STAGE(PG8_SB(1, 0), b3, voffB[0], voffB[1]); PG8_STAGE(PG8_SB(1, 1), b3 + hstepB, voffB[0], voffB[1]); PG8_STAGE(PG8_SA(1, 0), a3, s00, s01);
            PG8_WAIT_V(8); PG8_WAIT_L(0); PG8_BAR; PG8_MMA(1, 0, At, B0); PG8_MMA(1, 1, At, B1); PG8_BAR; PG8_SCHED;
        }
        if constexpr (ALIGN_EPI) { if (wr == 0) PG8_BAR; }
        if constexpr (ES == 1) asm volatile("s_nop 15\n\ts_nop 7" ::: "memory");
        const int le_ = fresh_lane(); const bool keep = E(acc, cur, wr, wc, le_ & 15, le_ >> 4, pre);
#ifdef EPI_REP
        if (!Epi::MAY_KEEP && (EPI_REP == 0 || EPI_REP == Epi::NSTORES)) { const int le2_ = fresh_lane(); (void)E(acc, cur, wr, wc, le2_ & 15, le2_ >> 4, pre); }
#endif
        if (!has_next) break;
        if (!(Epi::MAY_KEEP && keep)) {
#pragma unroll
        for (int a = 0; a < 2; ++a)
#pragma unroll
            for (int b = 0; b < 2; ++b)
#pragma unroll
                for (int m = 0; m < 4; ++m)
#pragma unroll
                    for (int n = 0; n < 2; ++n) acc[a][b][m][n] = (f32x4){0.f, 0.f, 0.f, 0.f};
        }
        cur = nxt; cA = nA; cB = nB; rot = nrot; ++ui;
        if (GATHER) { PG8_NVOFF(vA); }
        if constexpr (ALIGN_EPI) { if (wr == 1) PG8_BAR; }
    }
    PG8_WAIT_V(0);
    if constexpr (!ALIGN_EPI) { if (wr == 0) PG8_BAR; }
    PG8_BAR;
#undef PG8_SA
#undef PG8_SB
#undef PG8_STAGE
#undef PG8_LDA
#undef PG8_LDB
#undef PG8_MMA
#undef PG8_LD8
#undef PG8_WAIT_V
#undef PG8_WAIT_L
#undef PG8_BAR
#undef PG8_SCHED
#undef PG8_AVOFF
#undef PG8_NVOFF
}
}
#ifndef NO_KROT
#define KROT(pm, pn, nt) ((((pm) + (pn)) & 3) * ((nt) / 4))
#else
#define KROT(pm, pn, nt) 0
#endif
namespace pg8 {
constexpr size_t TSTEP = (size_t)256 * 1024 * 2;

struct OrdStatic {
    int nM, nN, nwg, G, c; const char *A, *B; size_t ts; int nt_ = 16;
    __device__ __forceinline__ void init(int M, int N, int G_, int c_, const void* A_, const void* B_, size_t ts_ = TSTEP) { nM = M / BM; nN = N / BM; nwg = nM * nN; G = G_; c = c_; A = (const char*)A_; B = (const char*)B_; ts = ts_; }
    __device__ __forceinline__ bool next(int i, Unit& u) const {
        const long L = (long)i * G + c; if (L >= nwg) return false;
        tile_map(xcd_remap((int)L, nwg), nM, nN, u.pm, u.pn); u.a = A + (size_t)u.pm * ts; u.b = B + (size_t)u.pn * ts; u.x0 = 0; u.x1 = 0; u.rot = KROT(u.pm, u.pn, nt_); return true;
    }
    __device__ __forceinline__ unsigned a_row(const Unit&, int r) const { return (unsigned)r; }
    __device__ __forceinline__ const char* list_base(const Unit&) const { return nullptr; }
    __device__ __forceinline__ unsigned row_of(const Unit&, int r, unsigned) const { return (unsigned)r; }
};
struct OrdInProj {
    int G, c; const char *A, *B;
    static constexpr int nM = 64, nN = 18, nwg = nM * nN;
    __device__ __forceinline__ bool next(int i, Unit& u) const {
        long L = (long)i * G + c;
        if (L < nwg) { tile_map(xcd_remap((int)L, nwg), nM, nN, u.pm, u.pn); u.a = A + (size_t)u.pm * TSTEP; u.b = B + (size_t)u.pn * TSTEP; u.x0 = 0; u.x1 = 0; return true; }
        L -= nwg; if (L >= 4) return false;
        u.pm = (int)(L >> 1); u.pn = 4 + (int)(L & 1); u.a = A + (size_t)(64 + u.pm) * TSTEP; u.b = B + (size_t)u.pn * TSTEP; u.x0 = 1; u.x1 = 0; return true;
    }
    __device__ __forceinline__ unsigned a_row(const Unit&, int r) const { return (unsigned)r; }
    __device__ __forceinline__ const char* list_base(const Unit&) const { return nullptr; }
    __device__ __forceinline__ unsigned row_of(const Unit&, int r, unsigned) const { return (unsigned)r; }
};
struct OrdInProj8 {
    int G, c; const char *A, *B;
    static constexpr int nM = 64, nN = 14, nwg = nM * nN; static constexpr size_t TS8 = (size_t)256 * 1024;
    __device__ __forceinline__ bool next(int i, Unit& u) const {
        if (c >= G) return false;
        long L = (long)i * G + c;
        if (L < nwg) { int j; tile_map(xcd_remap((int)L, nwg), nM, nN, u.pm, j); u.pn = j < 6 ? j : j + 4; u.a = A + (size_t)u.pm * TS8; u.b = B + (size_t)u.pn * TS8; u.x0 = 0; u.x1 = 0; return true; }
        L -= nwg; if (L >= 4) return false;
        u.pm = (int)(L >> 1); u.pn = 4 + (int)(L & 1); u.a = A + (size_t)(64 + u.pm) * TS8; u.b = B + (size_t)u.pn * TS8; u.x0 = 1; u.x1 = 0; return true;
    }
    __device__ __forceinline__ unsigned a_row(const Unit&, int r) const { return (unsigned)r; }
    __device__ __forceinline__ const char* list_base(const Unit&) const { return nullptr; }
    __device__ __forceinline__ unsigned row_of(const Unit&, int r, unsigned) const { return (unsigned)r; }
};
struct OrdInProjU {
    int G, c; const char *A, *B;
    static constexpr int nM = 64, nN = 4, nwg = nM * nN;
    __device__ __forceinline__ bool next(int i, Unit& u) const {
        const long L = (long)i * G + c; if (L >= nwg) return false;
        int j; tile_map(xcd_remap((int)L, nwg), nM, nN, u.pm, j); u.pn = 6 + j; u.a = A + (size_t)u.pm * TSTEP; u.b = B + (size_t)u.pn * TSTEP; u.x0 = 0; u.x1 = 0; return true;
    }
    __device__ __forceinline__ unsigned a_row(const Unit&, int r) const { return (unsigned)r; }
    __device__ __forceinline__ const char* list_base(const Unit&) const { return nullptr; }
    __device__ __forceinline__ unsigned row_of(const Unit&, int r, unsigned) const { return (unsigned)r; }
};
struct OrdMerge {
    int G, c; const char *A0, *A1, *B0, *B1;
    static constexpr int nM = 64, nN = 4, nwg = nM * nN;
    __device__ __forceinline__ bool next(int i, Unit& u) const {
        const long L = (long)(i >> 1) * G + c; if (L >= nwg) return false;
        tile_map(xcd_remap((int)L, nwg), nM, nN, u.pm, u.pn); const int p = i & 1;
        u.a = (p ? A1 : A0) + (size_t)u.pm * TSTEP; u.b = (p ? B1 : B0) + (size_t)u.pn * TSTEP; u.x0 = p; u.x1 = 0; u.rot = KROT(u.pm, u.pn, 16); return true;
    }
    __device__ __forceinline__ unsigned a_row(const Unit&, int r) const { return (unsigned)r; }
    __device__ __forceinline__ const char* list_base(const Unit&) const { return nullptr; }
    __device__ __forceinline__ unsigned row_of(const Unit&, int r, unsigned) const { return (unsigned)r; }
};
struct OrdMoe {
    int G, c, nN; const volatile PG8_LAS int* pt; const volatile PG8_LAS int* cn; const char *A, *B; size_t bstride, tstep; const int* list; int gather;
    __device__ __forceinline__ bool next(int i, Unit& u) const {
        if (c >= G) return false;
        const int total = __builtin_amdgcn_readfirstlane(pt[32]) * nN; const long L = (long)i * G + c; if (L >= total) return false;
        const int w = xcd_remap((int)L, total);
        const int ln_ = (int)(threadIdx.x & 63); const int ptl_ = pt[ln_ < 32 ? ln_ : 32];
        const unsigned long long bm_ = __ballot(ln_ < 32 && w >= ptl_ * nN);
        const int e = __builtin_amdgcn_readfirstlane(__builtin_popcountll(bm_) - 1);
        const int p0 = __builtin_amdgcn_readfirstlane(pt[e]), te = __builtin_amdgcn_readfirstlane(pt[e + 1]) - p0, loc = w - p0 * nN;
#ifndef MOE_PN_FAST
        u.pn = loc / te; const int mt = loc - u.pn * te; u.pm = p0 + mt; u.x0 = e; u.x1 = mt;
#else
        const int mt = loc / nN; u.pn = loc - mt * nN; u.pm = p0 + mt; u.x0 = e; u.x1 = mt; (void)te;
#endif
        u.a = gather ? A : A + (size_t)u.pm * tstep; u.b = B + (size_t)e * bstride + (size_t)u.pn * tstep; return true;
    }
    __device__ __forceinline__ unsigned a_row(const Unit& u, int r) const { const int rr = u.x1 * 256 + r; return rr < cn[u.x0] ? (unsigned)(list[u.x0 * 16384 + rr] >> 2) : 0u; }
    __device__ __forceinline__ const char* list_base(const Unit& u) const { return (const char*)(list + u.x0 * 16384 + u.x1 * 256); }
    __device__ __forceinline__ unsigned row_of(const Unit& u, int r, unsigned ent) const { const int rr = u.x1 * 256 + r; return rr < cn[u.x0] ? (ent >> 2) : 0u; }
};

struct EpiInProj {
    static constexpr int NSTORES = 16;
    struct Pre { f32x4 bv[2][2]; };
    __device__ __forceinline__ void prefetch(Pre& p, const Unit& u, int wr, int wc, int lane) const { const int ct = wc * 32 + 8 * (lane >> 4);
#pragma unroll
        for (int bj = 0; bj < 2; ++bj)
#pragma unroll
            for (int n = 0; n < 2; ++n) p.bv[bj][n] = *(const f32x4*)(bias + u.pn * 256 + bj * HALF + ct + 4 * n); }
    static constexpr bool PERM = true, MAY_KEEP = false;
    const float* bias; bf16_t *Q, *Kx, *U; size_t kv_stride, u_stride; const float *rc, *rs; float accs;
    __device__ __forceinline__ bool operator()(f32x4 (&acc)[2][2][4][2], const Unit& u, int wr, int wc, int fr, int fq, const Pre& pre) const {
        const int pn = u.pn, ctx = u.x0, ct = wc * 32 + 8 * fq;
        if (pn < 6) {
            const float sgn = fq < 2 ? -1.0f : 1.0f; const int p0 = 8 * (fq & 1);
#pragma unroll
            for (int ai = 0; ai < 2; ++ai)
#pragma unroll
                for (int m = 0; m < 4; ++m) {
                    const int rt = u.pm * BM + ai * HALF + wr * 64 + m * 16 + fr;
                    int b, l; if (ctx) { b = rt >> 8; l = rt & 255; } else { b = rt >> 13; l = rt & 8191; }
                    bf16_t* dst; float sc = 1.f; bool rope;
                    if (pn < 4) { dst = Q + (size_t)rt * 1024 + pn * 256; sc = ATT_C2; rope = true; }
                    else { const size_t erow = (size_t)b * 8448 + (ctx ? l : 256 + l); dst = Kx + (size_t)(pn - 4) * kv_stride + erow * 256; rope = (pn == 4) && !ctx; }
                    f32x4 cs[2], sn[2];
#pragma unroll
                    for (int n = 0; n < 2; ++n) { cs[n] = (f32x4){1.f, 1.f, 1.f, 1.f}; sn[n] = (f32x4){0.f, 0.f, 0.f, 0.f}; }
                    if (rope) { const int ti = (wc & 1) ? 128 + (l & 63) : (l >> 6);
#pragma unroll
                        for (int n = 0; n < 2; ++n) { cs[n] = *(const f32x4*)(rc + ti * 16 + p0 + 4 * n); sn[n] = *(const f32x4*)(rs + ti * 16 + p0 + 4 * n) * sgn; } }
#pragma unroll
                    for (int bj = 0; bj < 2; ++bj) {
                        f32x4 o[2];
#pragma unroll
                        for (int n = 0; n < 2; ++n) {
                            const f32x4 v = acc[ai][bj][m][n] * accs + pre.bv[bj][n]; f32x4 ot = v;
                            if (rope) {
#pragma unroll
                                for (int i = 0; i < 4; ++i) { const unsigned x = __float_as_uint(v[i]); auto r = __builtin_amdgcn_permlane32_swap(x, x, false, false); ot[i] = __uint_as_float(fq < 2 ? r[1] : r[0]); }
                            }
                            o[n] = rope ? (v * cs[n] + ot * sn[n]) * sc : v * sc;
                        }
                        u32x4 w; w.x = pk2(o[0][0], o[0][1]); w.y = pk2(o[0][2], o[0][3]); w.z = pk2(o[1][0], o[1][1]); w.w = pk2(o[1][2], o[1][3]);
                        *(u32x4*)(dst + bj * HALF + ct) = w;
                    }
                }
        } else {
            const int sel = (pn - 6) >> 2, cb = ((pn - 6) & 3) * 256; bf16_t* base = U + (size_t)sel * u_stride;
#pragma unroll
            for (int ai = 0; ai < 2; ++ai)
#pragma unroll
                for (int m = 0; m < 4; ++m) {
                    bf16_t* dst = base + (size_t)(u.pm * BM + ai * HALF + wr * 64 + m * 16 + fr) * 1024 + cb;
#pragma unroll
                    for (int bj = 0; bj < 2; ++bj) {
                        f32x4 v0 = acc[ai][bj][m][0] * accs + pre.bv[bj][0], v1 = acc[ai][bj][m][1] * accs + pre.bv[bj][1];
                        if (sel) { v0[0] = fsigmoid(v0[0]); v0[1] = fsigmoid(v0[1]); v0[2] = fsigmoid(v0[2]); v0[3] = fsigmoid(v0[3]); v1[0] = fsigmoid(v1[0]); v1[1] = fsigmoid(v1[1]); v1[2] = fsigmoid(v1[2]); v1[3] = fsigmoid(v1[3]); }
                        u32x4 w; w.x = pk2(v0[0], v0[1]); w.y = pk2(v0[2], v0[3]); w.z = pk2(v1[0], v1[1]); w.w = pk2(v1[2], v1[3]);
                        *(u32x4*)(dst + bj * HALF + ct) = w;
                    }
                }
        }
        return false;
    }
};
struct EpiMerge {
    static constexpr int NSTORES = 0;
    struct Pre {}; __device__ __forceinline__ void prefetch(Pre&, const Unit&, int, int, int) const {}
    static constexpr bool PERM = true, MAY_KEEP = true;
    const bf16_t *SA, *SP; unsigned char* O;
    __device__ __forceinline__ bool operator()(f32x4 (&acc)[2][2][4][2], const Unit& u, int wr, int wc, int fr, int fq, const Pre& pre) const {
        const int col0 = u.pn * BM + wc * 32 + 8 * fq;
#pragma unroll
        for (int ai = 0; ai < 2; ++ai)
#pragma unroll
            for (int m = 0; m < 4; ++m) {
                const size_t off = (size_t)(u.pm * BM + ai * HALF + wr * 64 + m * 16 + fr) * 1024 + col0;
#pragma unroll
                for (int bj = 0; bj < 2; ++bj) {
                    const u32x4 gp = *(const u32x4*)(SP + off + bj * HALF);
                    float sp[8] = {bflo(gp.x), bfhi(gp.x), bflo(gp.y), bfhi(gp.y), bflo(gp.z), bfhi(gp.z), bflo(gp.w), bfhi(gp.w)};
                    if (u.x0 == 0) {
                        const u32x4 ga = *(const u32x4*)(SA + off + bj * HALF);
                        float sa[8] = {bflo(ga.x), bfhi(ga.x), bflo(ga.y), bfhi(ga.y), bflo(ga.z), bfhi(ga.z), bflo(ga.w), bfhi(ga.w)};
#pragma unroll
                        for (int n = 0; n < 2; ++n)
#pragma unroll
                            for (int i = 0; i < 4; ++i) acc[ai][bj][m][n][i] *= sa[4 * n + i] * __builtin_amdgcn_rcpf(fmaxf(sp[4 * n + i], 1e-30f));
                    } else {
                        f32x4 v0 = acc[ai][bj][m][0], v1 = acc[ai][bj][m][1];
#pragma unroll
                        for (int i = 0; i < 4; ++i) { v0[i] *= MRG_SCALE * fmaxf(sp[i], 1e-30f); v1[i] *= MRG_SCALE * fmaxf(sp[4 + i], 1e-30f); }
                        u32x2 w; w.x = pk4_fp8(v0[0], v0[1], v0[2], v0[3]); w.y = pk4_fp8(v1[0], v1[1], v1[2], v1[3]);
                        __builtin_amdgcn_raw_buffer_store_b64(w, __builtin_amdgcn_make_buffer_rsrc((void*)O, 0, 0x7fffffff, 0x00020000), (int)(off + bj * HALF), 0, 16  );
                    }
                }
            }
        return u.x0 == 0;
    }
};
struct EpiOut {
    static constexpr int NSTORES = 16;
    struct Pre {}; __device__ __forceinline__ void prefetch(Pre&, const Unit&, int, int, int) const {}
    static constexpr bool PERM = true, MAY_KEEP = false;
    const float* modx; bf16_t* delta;
    __device__ __forceinline__ bool operator()(f32x4 (&acc)[2][2][4][2], const Unit& u, int wr, int wc, int fr, int fq, const Pre& pre) const {
        const int col0 = u.pn * BM + wc * 32 + 8 * fq; const int b = (u.pm * BM) >> 13;
        f32x4 g[2][2];
#pragma unroll
        for (int bj = 0; bj < 2; ++bj)
#pragma unroll
            for (int n = 0; n < 2; ++n) g[bj][n] = *(const f32x4*)(modx + b * 6144 + 2048 + col0 + bj * HALF + 4 * n) * (1.0f / (MRG_SCALE * MOE_WSCALE));
#pragma unroll
        for (int ai = 0; ai < 2; ++ai)
#pragma unroll
            for (int m = 0; m < 4; ++m) {
                const size_t off = (size_t)(u.pm * BM + ai * HALF + wr * 64 + m * 16 + fr) * 1024 + col0;
#pragma unroll
                for (int bj = 0; bj < 2; ++bj) { const f32x4 v0 = g[bj][0] * acc[ai][bj][m][0], v1 = g[bj][1] * acc[ai][bj][m][1];
                    u32x4 w; w.x = pk2(v0[0], v0[1]); w.y = pk2(v0[2], v0[3]); w.z = pk2(v1[0], v1[1]); w.w = pk2(v1[2], v1[3]); __builtin_amdgcn_raw_buffer_store_b128(w, __builtin_amdgcn_make_buffer_rsrc((void*)delta, 0, 0x7fffffff, 0x00020000), (int)((off + bj * HALF) * 2), 0, 16  ); }
            }
        return false;
    }
};
struct EpiSwiglu {
    static constexpr int NSTORES = 8;
    struct Pre { f32x4 bg[2], bl[2]; };
    __device__ __forceinline__ void prefetch(Pre& p, const Unit& u, int wr, int wc, int lane) const { const int ca = u.pn * HALF + wc * 32 + 8 * (lane >> 4); const float* be = bgu + (size_t)u.x0 * 2048;
#pragma unroll
        for (int n = 0; n < 2; ++n) { p.bg[n] = *(const f32x4*)(be + ca + 4 * n); p.bl[n] = *(const f32x4*)(be + 1024 + ca + 4 * n); } }
    static constexpr bool PERM = true, MAY_KEEP = false;
    const float* bgu; unsigned char* ACT;
    __device__ __forceinline__ bool operator()(f32x4 (&acc)[2][2][4][2], const Unit& u, int wr, int wc, int fr, int fq, const Pre& pre) const {
        const int ca = u.pn * HALF + wc * 32 + 8 * fq; constexpr float iw = 1.0f / MOE_WSCALE;
        f32x4 bg[2], bl[2];
#pragma unroll
        for (int n = 0; n < 2; ++n) { bg[n] = pre.bg[n]; bl[n] = pre.bl[n]; }
#pragma unroll
        for (int ai = 0; ai < 2; ++ai)
#pragma unroll
            for (int m = 0; m < 4; ++m) {
                unsigned char* dst = ACT + (size_t)(u.pm * BM + ai * HALF + wr * 64 + m * 16 + fr) * 1024 + ca;
                float o[8];
#pragma unroll
                for (int n = 0; n < 2; ++n)
#pragma unroll
                    for (int i = 0; i < 4; ++i) {
                        const float gt = fminf(acc[ai][0][m][n][i] * iw + bg[n][i], 7.0f);
                        const float ln = fminf(fmaxf(acc[ai][1][m][n][i] * iw + bl[n][i], -7.0f), 7.0f);
                        o[4 * n + i] = (MOE_ASCALE * gt) * fsigmoid(1.702f * gt) * (ln + 1.0f);
                    }
                u32x2 w; w.x = pk4_fp8(o[0], o[1], o[2], o[3]); w.y = pk4_fp8(o[4], o[5], o[6], o[7]);
                *(u32x2*)dst = w;
            }
        return false;
    }
};
struct EpiDown {
    static constexpr int NSTORES = 0;
    struct Pre { int ent[2][4]; f32x4 bv[2][2]; };
    static constexpr bool PERM = true, MAY_KEEP = false;
    const float* bd; unsigned char* Y2; const int* list; const volatile PG8_LAS int* cn;
    __device__ __forceinline__ void prefetch(Pre& p, const Unit& u, int wr, int wc, int lane) const {
        const int cnt = cn[u.x0], fr = lane & 15;
#pragma unroll
        for (int ai = 0; ai < 2; ++ai)
#pragma unroll
            for (int m = 0; m < 4; ++m) { const int rr = u.x1 * 256 + ai * HALF + wr * 64 + m * 16 + fr; p.ent[ai][m] = rr < cnt ? list[u.x0 * 16384 + rr] : -1; }
        const int col0 = u.pn * BM + wc * 32 + 8 * (lane >> 4); const float* be = bd + (size_t)u.x0 * 1024;
#pragma unroll
        for (int bj = 0; bj < 2; ++bj)
#pragma unroll
            for (int n = 0; n < 2; ++n) p.bv[bj][n] = *(const f32x4*)(be + col0 + bj * HALF + 4 * n);
    }
    __device__ __forceinline__ bool operator()(f32x4 (&acc)[2][2][4][2], const Unit& u, int wr, int wc, int fr, int fq, const Pre& pre) const {
        const int col0 = u.pn * BM + wc * 32 + 8 * fq; constexpr float iws = Y2_SCALE / (MOE_WSCALE * MOE_ASCALE); const int odd = fq & 1;
        f32x4 bv[2][2];
#pragma unroll
        for (int bj = 0; bj < 2; ++bj)
#pragma unroll
            for (int n = 0; n < 2; ++n) bv[bj][n] = pre.bv[bj][n] * Y2_SCALE;
#pragma unroll
        for (int ai = 0; ai < 2; ++ai)
#pragma unroll
            for (int mp = 0; mp < 2; ++mp) {
                const int ent = odd ? pre.ent[ai][2 * mp + 1] : pre.ent[ai][2 * mp];
#pragma unroll
                for (int bj = 0; bj < 2; ++bj) {
                    u32x2 w[2];
#pragma unroll
                    for (int mm = 0; mm < 2; ++mm) { const int m = 2 * mp + mm; const f32x4 v0 = acc[ai][bj][m][0] * iws + bv[bj][0], v1 = acc[ai][bj][m][1] * iws + bv[bj][1];
                        w[mm].x = pk4_fp8(v0[0], v0[1], v0[2], v0[3]); w[mm].y = pk4_fp8(v1[0], v1[1], v1[2], v1[3]); }
                    const u32x2 send = odd ? w[0] : w[1], keep = odd ? w[1] : w[0];
                    u32x2 recv; recv.x = (unsigned)__shfl_xor((int)send.x, 16); recv.y = (unsigned)__shfl_xor((int)send.y, 16);
                    const u32x4 o16 = odd ? (u32x4){recv.x, recv.y, keep.x, keep.y} : (u32x4){keep.x, keep.y, recv.x, recv.y};
                    if (ent >= 0) *(u32x4*)(Y2 + (size_t)ent * 1024 + col0 - 8 * odd + bj * HALF) = o16;
                }
            }
        return false;
    }
};
}
namespace attn_body {
using bf16=__hip_bfloat16;
using bf16x8=__attribute__((ext_vector_type(8)))short;
using s16x4=__attribute__((ext_vector_type(4)))short;
using f32x16=__attribute__((ext_vector_type(16)))float;
using u32x4=__attribute__((ext_vector_type(4)))unsigned;
constexpr int BATCH=2,NHEAD=16,SEQ=8192,D=64,DM=NHEAD*D;
constexpr int NW=8,QBLK=32,QB=QBLK*NW,KVBLK=64,NQB=SEQ/QB;
constexpr int UROWS=128;
constexpr int ATTN_PITCH=DM, ATTN_UNIT_ROWS=QB;
constexpr int KP=256, KVROWS=8448, CTXT=4;
__device__ __forceinline__ int crow(int r,int hi){return (r&3)+8*(r>>2)+4*hi;}
#define SBAR() __builtin_amdgcn_sched_barrier(0)
__device__ __forceinline__ void cmask(f32x16&p0,f32x16&p1,int db,int hi){
  const float NEG=-INFINITY; const int kb=db+4*hi;
  #pragma unroll
  for(int r=0;r<16;++r){const int kv=kb+(r&3)+8*(r>>2); if((unsigned)kv>256u)p0[r]=NEG; if((unsigned)(kv+32)>256u)p1[r]=NEG;}
}

constexpr int NSLOT=3, SLOTB=8192;
constexpr int LDS_K=0, LDS_V=NSLOT*SLOTB, LDS_WS=2*NSLOT*SLOTB, LDS_OST=LDS_WS+NW*64*4, LDS_BYTES=LDS_OST+NW*4096;
constexpr float C2=0.125f*1.4426950408889634f;
__device__ __forceinline__ void glds16(const void*gsrc,unsigned lds_dst){unsigned keep;
  asm volatile("s_mov_b32 %0, m0\n\ts_mov_b32 m0, %2\n\ts_nop 0\n\tglobal_load_lds_dwordx4 %1, off\n\ts_mov_b32 m0, %0":"=&s"(keep):"v"(gsrc),"s"(lds_dst):"memory");}
__device__ __forceinline__ float max3f(float a,float b,float c){float r;asm("v_max3_f32 %0, %1, %2, %3":"=v"(r):"v"(a),"v"(b),"v"(c));return r;}
__device__ __forceinline__ float max2f(float a,float b){float r;asm("v_max_f32_e32 %0, %1, %2":"=v"(r):"v"(a),"v"(b));return r;}
__device__ __forceinline__ float fadd_s(float a,float b){float r;asm("v_add_f32_e32 %0, %1, %2":"=v"(r):"v"(a),"v"(b));return r;}
__device__ __forceinline__ float fsub_s(float a,float b){float r;asm("v_sub_f32_e32 %0, %1, %2":"=v"(r):"v"(a),"v"(b));return r;}
typedef float f32x2_t __attribute__((ext_vector_type(2))); typedef __bf16 bf16x2_t __attribute__((ext_vector_type(2)));
__device__ __forceinline__ unsigned cvtpk_s(float lo,float hi){f32x2_t v={lo,hi};bf16x2_t b=__builtin_convertvector(v,bf16x2_t);return __builtin_bit_cast(unsigned,b);}
#define WAIT_BAR(N) asm volatile("s_waitcnt vmcnt(" #N ") lgkmcnt(0)\n\ts_barrier":::"memory")

__device__ __forceinline__ void qkt(f32x16&p0,f32x16&p1,const char*Kslot,const bf16x8*qr,const f32x16&negm,int r32,int hi){
  const char*kb=Kslot+hi*1024+r32*16;
  #pragma unroll
  for(int d0=0;d0<4;++d0){
    const bf16x8 b0=*reinterpret_cast<const bf16x8*>(kb+d0*2048);
    const bf16x8 b1=*reinterpret_cast<const bf16x8*>(kb+d0*2048+512);
    if(d0==0){p0=__builtin_amdgcn_mfma_f32_32x32x16_bf16(b0,qr[0],negm,0,0,0);p1=__builtin_amdgcn_mfma_f32_32x32x16_bf16(b1,qr[0],negm,0,0,0);}
    else{p0=__builtin_amdgcn_mfma_f32_32x32x16_bf16(b0,qr[d0],p0,0,0,0);p1=__builtin_amdgcn_mfma_f32_32x32x16_bf16(b1,qr[d0],p1,0,0,0);}}
}
typedef __attribute__((address_space(3))) const char* lds_cptr;
typedef short v4i16_t __attribute__((ext_vector_type(4)));
__device__ __forceinline__ void kload8(bf16x8*kf,lds_cptr kp){
  kf[0]=*(const __attribute__((address_space(3))) bf16x8*)(kp);      kf[1]=*(const __attribute__((address_space(3))) bf16x8*)(kp+512);
  kf[2]=*(const __attribute__((address_space(3))) bf16x8*)(kp+2048); kf[3]=*(const __attribute__((address_space(3))) bf16x8*)(kp+2560);
  kf[4]=*(const __attribute__((address_space(3))) bf16x8*)(kp+4096); kf[5]=*(const __attribute__((address_space(3))) bf16x8*)(kp+4608);
  kf[6]=*(const __attribute__((address_space(3))) bf16x8*)(kp+6144); kf[7]=*(const __attribute__((address_space(3))) bf16x8*)(kp+6656);
}
__device__ __forceinline__ void kload2(bf16x8*kf,lds_cptr kp,int j){ kf[2*j]=*(const __attribute__((address_space(3))) bf16x8*)(kp+j*2048); kf[2*j+1]=*(const __attribute__((address_space(3))) bf16x8*)(kp+j*2048+512); }
__device__ __forceinline__ s16x4 vtr(lds_cptr p){ return __builtin_bit_cast(s16x4,__builtin_amdgcn_ds_read_tr16_b64_v4i16((__attribute__((address_space(3))) v4i16_t*)p)); }
__device__ __forceinline__ float rowmax(const f32x16&p0,const f32x16&p1){
  float a=max3f(p0[0],p0[1],p1[0]),b=max3f(p0[2],p0[3],p1[1]);a=max3f(a,p1[2],p1[3]);
  #pragma unroll
  for(int r=4;r<16;r+=4){a=max3f(a,p0[r],p0[r+1]);b=max3f(b,p0[r+2],p0[r+3]);a=max3f(a,p1[r],p1[r+1]);b=max3f(b,p1[r+2],p1[r+3]);}
  const float m=max2f(a,b);
  auto rr=__builtin_amdgcn_permlane32_swap(__float_as_uint(m),__float_as_uint(m),false,false);
  return max2f(__uint_as_float(rr[0]),__uint_as_float(rr[1]));
}
__device__ __forceinline__ void pv(f32x16*o,int vb,bf16x8 pa0,bf16x8 pa1,bf16x8 pa2,bf16x8 pa3){
  #pragma unroll
  for(int d0=0;d0<2;++d0){s16x4 lo[4],hi[4];
    #pragma unroll
    for(int ks=0;ks<4;++ks){
      asm volatile("ds_read_b64_tr_b16 %0,%1 offset:%c2":"=&v"(lo[ks]):"v"(vb),"i"(d0*4096+ks*1024):"memory");
      asm volatile("ds_read_b64_tr_b16 %0,%1 offset:%c2":"=&v"(hi[ks]):"v"(vb),"i"(d0*4096+ks*1024+512):"memory");}
    asm volatile("s_waitcnt lgkmcnt(0)":::"memory");SBAR();
    #define PK(k) (bf16x8){lo[k][0],lo[k][1],lo[k][2],lo[k][3],hi[k][0],hi[k][1],hi[k][2],hi[k][3]}
    o[d0]=__builtin_amdgcn_mfma_f32_32x32x16_bf16(pa0,PK(0),o[d0],0,0,0);
    o[d0]=__builtin_amdgcn_mfma_f32_32x32x16_bf16(pa1,PK(1),o[d0],0,0,0);
    o[d0]=__builtin_amdgcn_mfma_f32_32x32x16_bf16(pa2,PK(2),o[d0],0,0,0);
    o[d0]=__builtin_amdgcn_mfma_f32_32x32x16_bf16(pa3,PK(3),o[d0],0,0,0);
    #undef PK
  }
}

#ifndef ATTN_STORE16
#define ATTN_STORE16(p,v) (*(u32x4*)(p)=(v))
#endif
template<int THRL> __device__ __forceinline__ void attn_unit(int b,int h,int qb,const bf16*Q,const bf16*__restrict__ K,const bf16*__restrict__ V,bf16*O,const float*sink,char*shm){
  const int tid=threadIdx.x,lane=tid&63,r32=lane&31,hi=lane>>5; const int wid=__builtin_amdgcn_readfirstlane(tid>>6);
  const long rowbase=(long)b*SEQ; const int q0=qb*UROWS;
  const int hw=2*h+(wid>>2), wq=(wid&3)*QBLK;
  const bf16*Qw=Q+(rowbase+q0+wq)*DM+hw*D;
  const bf16*Kh=K+(long)b*KVROWS*KP+(h>>1)*D,*Vh=V+(long)b*KVROWS*KP+(h>>1)*D;
  const int jlo=(q0>=128)?(q0-128):0, jhi=(q0+UROWS+128<=SEQ)?(q0+UROWS+128):SEQ; const int TLO=CTXT+jlo/KVBLK;
  #define TIX(t) (((t)<CTXT)?(t):(TLO+(t)-CTXT))
  const unsigned lds0=(unsigned)(uintptr_t)shm;
  float*wsf=(float*)(shm+LDS_WS)+wid*64;
  const bf16*ksrc=Kh+(long)lane*KP+wid*8;
  const bf16*vsrc=Vh+(long)(16*(wid&3)+(lane>>2))*KP+(wid>>2)*32+(lane&3)*8;
  const unsigned kdst=lds0+LDS_K+wid*1024, vdst=lds0+LDS_V+wid*1024;
  #define DMA_K(t,slot) glds16(ksrc+(long)TIX(t)*KVBLK*KP,(unsigned)__builtin_amdgcn_readfirstlane(kdst+(slot)))
  #define DMA_V(t,slot) glds16(vsrc+(long)TIX(t)*KVBLK*KP,(unsigned)__builtin_amdgcn_readfirstlane(vdst+(slot)))
  const int vb0=(int)(lds0+LDS_V)+((lane>>4)&1)*32+(lane&3)*8+(4*hi+((lane&15)>>2))*64;
  const char*Kbase=shm+LDS_K; bf16x8 kf[8];
  const lds_cptr shm3=(lds_cptr)shm; const lds_cptr kp0=shm3+LDS_K+hi*1024+r32*16; const lds_cptr vp0=shm3+LDS_V+((lane>>4)&1)*32+(lane&3)*8+(4*hi+((lane&15)>>2))*64;
  const int NT=CTXT+(jhi-jlo)/KVBLK;
  DMA_K(0,0);DMA_V(0,0);DMA_K(1,SLOTB);
  bf16x8 qr[4];
  #pragma unroll
  for(int d0=0;d0<4;++d0)qr[d0]=*reinterpret_cast<const bf16x8*>(&Qw[(long)r32*DM+d0*16+hi*8]);
  float mhat=0.f,l_reg=0.f;f32x16 o[2];o[0]=f32x16{};o[1]=f32x16{};f32x16 negm=f32x16{};asm volatile("":"+v"(negm));
  const int qpos=q0+wq+r32;
  #define CMASK(P0,P1,t) do{ if((t)>=CTXT){ cmask(P0,P1,(TIX(t)-CTXT)*KVBLK-qpos+128,hi); } }while(0)
  bool resc=false;
  #define START(P0,P1) do{ const float rm=rowmax(P0,P1); resc=false; \
    { const float dl=rm; mhat=fadd_s(mhat,dl); \
      _Pragma("unroll") for(int r=0;r<16;++r){P0[r]=fsub_s(P0[r],dl);P1[r]=fsub_s(P1[r],dl);} \
      _Pragma("unroll") for(int r=0;r<16;++r)negm[r]=-mhat; asm volatile("":"+v"(negm)); } \
    _Pragma("unroll") for(int r=0;r<16;++r)P0[r]=__builtin_amdgcn_exp2f(P0[r]); }while(0)
  #define RESC() do{ if(resc){ asm volatile("s_waitcnt lgkmcnt(0)":::"memory"); \
      _Pragma("unroll") for(int d_=0;d_<2;++d_) _Pragma("unroll") for(int r=0;r<16;++r)o[d_][r]*=wsf[crow(r,hi)]; } }while(0)
  f32x16 pA0,pA1,pB0,pB1;
  int sl_prev=0,sl_cur=0,sl_next=SLOTB;
  #define ROT() do{sl_prev=sl_cur;sl_cur=sl_next;sl_next=(sl_next==(NSLOT-1)*SLOTB)?0:sl_next+SLOTB;}while(0)
  DMA_K(2,2*SLOTB);
  WAIT_BAR(3);
  qkt(pA0,pA1,Kbase,qr,negm,r32,hi);asm volatile("s_nop 15\n\ts_nop 7":"+v"(pA0),"+v"(pA1));CMASK(pA0,pA1,0);
  START(pA0,pA1);
  _Pragma("unroll") for(int r=0;r<16;++r)pA1[r]=__builtin_amdgcn_exp2f(pA1[r]);
  WAIT_BAR(0);
  DMA_K(3,0);DMA_V(1,SLOTB);
  ROT();
  kload8(kf,kp0+sl_cur);
  WAIT_BAR(2);
  s16x4 vlo[8],vhi[8]; u32x4 pw0,pw1,pw2,pw3;
  #define PKW(P,B) cvtpk_s(P[B],P[B+1])
  #define PAF(k) __builtin_bit_cast(bf16x8,pw##k)
  #define VFR(i) (bf16x8){vlo[i][0],vlo[i][1],vlo[i][2],vlo[i][3],vhi[i][0],vhi[i][1],vhi[i][2],vhi[i][3]}
  #define PIN(x) asm volatile("":"+v"(x))
  #define MX3(a,b,c) __builtin_fmaxf(__builtin_fmaxf((a),(b)),(c))
  #define GAPA(MF,A0,A1,A2,A3,W0,W1,PW) do{ MF; sacc+=A0; sacc+=A1; sacc+=A2; sacc+=A3; PIN(sacc); W0; W1; PIN(PW); SBAR(); }while(0)
  #define EX(v) __builtin_amdgcn_exp2f(v)
  #define GAPB(MF,X,B) do{ MF; X[B]=EX(X[B]); X[B+1]=EX(X[B+1]); X[B+2]=EX(X[B+2]); X[B+3]=EX(X[B+3]); PIN(X); SBAR(); }while(0)
  #define VRD(i) do{ vlo[i]=vtr(vp_+(((i)>>2)*4096+((i)&3)*1024)); vhi[i]=vtr(vp_+(((i)>>2)*4096+((i)&3)*1024+512)); }while(0)
  #define KRD(G,j) do{ if(G){ kload2(kf,kp0+sl_next,j); SBAR(); } }while(0)
  #define STEP(C0,C1,P0,P1,t,GK,GV,GL) do{ SBAR(); \
    const lds_cptr vp_=vp0+sl_prev; \
    VRD(0); SBAR(); float sacc=(P0[0]+P0[1]); \
    GAPA(C0=__builtin_amdgcn_mfma_f32_32x32x16_bf16(kf[0],qr[0],negm,0,0,0), P0[2],P0[3],P0[4],P0[5],     pw0[0]=PKW(P0,0), pw0[1]=PKW(P0,2), pw0); \
    VRD(4); SBAR(); GAPA(C1=__builtin_amdgcn_mfma_f32_32x32x16_bf16(kf[1],qr[0],negm,0,0,0), P0[6],P0[7],P0[8],P0[9],     pw0[2]=PKW(P0,4), pw0[3]=PKW(P0,6), pw0); \
    VRD(1); SBAR(); GAPA(C0=__builtin_amdgcn_mfma_f32_32x32x16_bf16(kf[2],qr[1],C0,0,0,0),   P0[10],P0[11],P0[12],P0[13], pw1[0]=PKW(P0,8), pw1[1]=PKW(P0,10), pw1); \
    VRD(5); SBAR(); GAPA(C1=__builtin_amdgcn_mfma_f32_32x32x16_bf16(kf[3],qr[1],C1,0,0,0),   P0[14],P0[15],P1[0],P1[1],   pw1[2]=PKW(P0,12),pw1[3]=PKW(P0,14), pw1); \
    VRD(2); SBAR(); GAPA(C0=__builtin_amdgcn_mfma_f32_32x32x16_bf16(kf[4],qr[2],C0,0,0,0),   P1[2],P1[3],P1[4],P1[5],     pw2[0]=PKW(P1,0), pw2[1]=PKW(P1,2), pw2); \
    VRD(6); SBAR(); GAPA(C1=__builtin_amdgcn_mfma_f32_32x32x16_bf16(kf[5],qr[2],C1,0,0,0),   P1[6],P1[7],P1[8],P1[9],     pw2[2]=PKW(P1,4), pw2[3]=PKW(P1,6), pw2); \
    VRD(3); SBAR(); GAPA(C0=__builtin_amdgcn_mfma_f32_32x32x16_bf16(kf[6],qr[3],C0,0,0,0),   P1[10],P1[11],P1[12],P1[13], pw3[0]=PKW(P1,8), pw3[1]=PKW(P1,10), pw3); \
    VRD(7); SBAR(); GAPA(C1=__builtin_amdgcn_mfma_f32_32x32x16_bf16(kf[7],qr[3],C1,0,0,0),   P1[14],P1[15],0.f,0.f,       pw3[2]=PKW(P1,12),pw3[3]=PKW(P1,14), pw3); \
    l_reg+=sacc; \
    if(GK){DMA_K((t)+3,sl_cur);} if(GV){DMA_V((t)+1,sl_next);} \
    CMASK(C0,C1,t); \
    { float a=MX3(C0[0],C0[1],C1[0]),b=MX3(C0[2],C0[3],C1[1]); a=MX3(a,C1[2],C1[3]); \
      _Pragma("unroll") for(int r=4;r<16;r+=4){a=MX3(a,C0[r],C0[r+1]);b=MX3(b,C0[r+2],C0[r+3]);a=MX3(a,C1[r],C1[r+1]);b=MX3(b,C1[r+2],C1[r+3]);} \
      float rm=__builtin_fmaxf(a,b); { auto rr=__builtin_amdgcn_permlane32_swap(__float_as_uint(rm),__float_as_uint(rm),false,false); rm=__builtin_fmaxf(__uint_as_float(rr[0]),__uint_as_float(rr[1])); } \
      resc=false; \
      if(__builtin_expect(__any(rm>(float)THRL),0)){ const float dl=__builtin_fmaxf(rm,0.f); mhat+=dl; \
        _Pragma("unroll") for(int r=0;r<16;++r){C0[r]-=dl;C1[r]-=dl;} \
        _Pragma("unroll") for(int r=0;r<16;++r)negm[r]=-mhat; asm volatile("":"+v"(negm)); \
        const float f=__builtin_amdgcn_exp2f(-dl); l_reg*=f; if(hi==0)wsf[r32]=f; resc=true; } } \
    SBAR(); \
    GAPB(o[0]=__builtin_amdgcn_mfma_f32_32x32x16_bf16(PAF(0),VFR(0),o[0],0,0,0), C0,0); \
    GAPB(o[1]=__builtin_amdgcn_mfma_f32_32x32x16_bf16(PAF(0),VFR(4),o[1],0,0,0), C0,4); \
    KRD(GL,0); GAPB(o[0]=__builtin_amdgcn_mfma_f32_32x32x16_bf16(PAF(1),VFR(1),o[0],0,0,0), C0,8); \
    KRD(GL,1); GAPB(o[1]=__builtin_amdgcn_mfma_f32_32x32x16_bf16(PAF(1),VFR(5),o[1],0,0,0), C0,12); \
    KRD(GL,2); GAPB(o[0]=__builtin_amdgcn_mfma_f32_32x32x16_bf16(PAF(2),VFR(2),o[0],0,0,0), C1,0); \
    KRD(GL,3); GAPB(o[1]=__builtin_amdgcn_mfma_f32_32x32x16_bf16(PAF(2),VFR(6),o[1],0,0,0), C1,4); \
    GAPB(o[0]=__builtin_amdgcn_mfma_f32_32x32x16_bf16(PAF(3),VFR(3),o[0],0,0,0), C1,8); \
    GAPB(o[1]=__builtin_amdgcn_mfma_f32_32x32x16_bf16(PAF(3),VFR(7),o[1],0,0,0), C1,12); \
    }while(0)
  int t=1;
  #undef CMASK
  #define CMASK(P0,P1,t) do{ if((t)>=CTXT){ cmask(P0,P1,(TIX(t)-CTXT)*KVBLK-qpos+128,hi); } }while(0)
  #define ENDW(tt) do{ if((tt)+3<NT){WAIT_BAR(2);} else if((tt)+2<NT){WAIT_BAR(1);} else {WAIT_BAR(0);} }while(0)
  for(;t+1<NT;t+=2){
    STEP(pB0,pB1,pA0,pA1,t,(t+3<NT),(t+1<NT),(t+1<NT));       ENDW(t);   RESC(); ROT();
    STEP(pA0,pA1,pB0,pB1,t+1,(t+4<NT),(t+2<NT),(t+2<NT));     ENDW(t+1); RESC(); ROT();
  }
  STEP(pB0,pB1,pA0,pA1,NT-1,false,false,false); RESC();
  { float sacc=pB0[0]+pB0[1]; _Pragma("unroll") for(int r=2;r<16;++r)sacc+=pB0[r]; _Pragma("unroll") for(int r=0;r<16;++r)sacc+=pB1[r]; l_reg+=sacc;
    pw0=(u32x4){PKW(pB0,0),PKW(pB0,2),PKW(pB0,4),PKW(pB0,6)};pw1=(u32x4){PKW(pB0,8),PKW(pB0,10),PKW(pB0,12),PKW(pB0,14)};pw2=(u32x4){PKW(pB1,0),PKW(pB1,2),PKW(pB1,4),PKW(pB1,6)};pw3=(u32x4){PKW(pB1,8),PKW(pB1,10),PKW(pB1,12),PKW(pB1,14)};
    SBAR(); pv(o,vb0+sl_cur,PAF(0),PAF(1),PAF(2),PAF(3)); }
  #undef PKW
  #undef PAF
  #undef VFR
  #undef PIN
  #undef MX3
  #undef GAPA
  #undef GAPB
  #undef EX
  #undef VRD
  #undef KRD
  #undef STEP
  #undef ENDW
  {auto rr=__builtin_amdgcn_permlane32_swap(__float_as_uint(l_reg),__float_as_uint(l_reg),false,false);l_reg=__uint_as_float(rr[0])+__uint_as_float(rr[1]);}
  l_reg+=__builtin_amdgcn_exp2f(sink[hw]*1.4426950408889634f-mhat);
  if(hi==0)wsf[32+r32]=l_reg;asm volatile("s_waitcnt lgkmcnt(0)":::"memory");
  float rli[16];
  #pragma unroll
  for(int r=0;r<16;++r)rli[r]=__builtin_amdgcn_rcpf(wsf[32+crow(r,hi)]);
  bf16*Ow=O+(rowbase+q0+wq)*DM+hw*D;
  { bf16*stg=(bf16*)(shm+LDS_OST)+wid*2048;
    #pragma unroll
    for(int r=0;r<16;++r){const int orow=crow(r,hi);
      #pragma unroll
      for(int d0=0;d0<2;++d0)stg[orow*64+d0*32+r32]=__float2bfloat16(o[d0][r]*rli[r]);}
    asm volatile("s_waitcnt lgkmcnt(0)":::"memory");
    #pragma unroll
    for(int i=0;i<4;++i){const int row=i*8+(lane>>3),ch=lane&7; const u32x4 v=*(const u32x4*)(stg+row*64+ch*8); ATTN_STORE16(Ow+(long)row*DM+ch*8,v);} }
  asm volatile("s_waitcnt lgkmcnt(0)\n\ts_barrier":::"memory");
  #undef DMA_K
  #undef TIX
  #undef DMA_V
  #undef CMASK
  #undef START
  #undef RESC
  #undef ROT
}
constexpr int ATTN_LDS_BYTES=LDS_BYTES;
struct AttnTensors { const bf16* Q; const bf16* K; const bf16* V; bf16* O; const float* sink; };
struct AttnUnit { int bh; int qb; };
struct StaticOrder {
  int na, blk;
  __device__ __forceinline__ explicit StaticOrder(int na_,int block):na(na_),blk(block){}
  __device__ __forceinline__ bool next(int i,AttnUnit&u)const{ if(blk>=na)return false; const int un=i*na+blk; if(un>=1024)return false; u.bh=un>>6; u.qb=un&63; return true; }
  __device__ __forceinline__ void a_ready(const AttnUnit&)const{}
  __device__ __forceinline__ void done(const AttnUnit&)const{}
};
template<class Sched,int THRL=8> __device__ __forceinline__ void attn_phase(char*lds,const AttnTensors&T,const Sched&S){
  AttnUnit u;
  for(int i=0;S.next(i,u);++i){ S.a_ready(u); attn_unit<THRL>(u.bh>>3,u.bh&7,u.qb,T.Q,T.K,T.V,T.O,T.sink,lds); S.done(u); }
}
#undef SBAR
#undef WAIT_BAR
}
#define GAS __attribute__((address_space(1)))
#define LAS __attribute__((address_space(3)))
typedef unsigned short bf16;
typedef unsigned v4u __attribute__((ext_vector_type(4)));
typedef float f32x4 __attribute__((ext_vector_type(4)));
typedef short bf16x8 __attribute__((ext_vector_type(8)));
typedef GAS unsigned gu32;
typedef GAS unsigned long long gu64;
#define RLX_AGENT __ATOMIC_RELAXED, __HIP_MEMORY_SCOPE_AGENT
#define LDS_WAIT() asm volatile("s_waitcnt lgkmcnt(0)" ::: "memory")
#define VM_WAIT() asm volatile("s_waitcnt vmcnt(0)" ::: "memory")
__device__ __forceinline__ unsigned long long rt() { return __builtin_amdgcn_s_memrealtime(); }
#define XB_TMO      128
#define XB_XCNT(j)  (256  + 64 * (j))
#define XB_XSUB(j)  (1280 + 64 * (j))
#define XB_XGEN(j)  (2304 + 64 * (j))
#define XB_TOP      3328
#define XB_TOPGEN   3392
#define XCD_BAR_WORDS 3456
#define XB_SPIN_CAP (1u << 18)

__device__ __forceinline__ unsigned xb_ld(unsigned* p)              { return __hip_atomic_load(p, __ATOMIC_RELAXED, __HIP_MEMORY_SCOPE_AGENT); }
__device__ __forceinline__ unsigned xb_add(unsigned* p, unsigned v) { return __hip_atomic_fetch_add(p, v, __ATOMIC_RELAXED, __HIP_MEMORY_SCOPE_AGENT); }
__device__ __forceinline__ unsigned xb_xcc_id() { return (unsigned)__builtin_amdgcn_s_getreg((3 << 11) | 20) & 0xFu; }
#define XB_SPIN(cond, bar) do { unsigned _sp = 0; while (cond) { __builtin_amdgcn_s_sleep(1); \
    if ((++_sp & 255u) == 0u) { if (xb_ld(&(bar)[XB_TMO])) break; if (_sp > XB_SPIN_CAP) { atomicAdd(&(bar)[XB_TMO], 1u); break; } } } } while (0)

struct XcdBarrier {
    unsigned* bar; unsigned x;
    volatile LAS unsigned* st;
};

__device__ __forceinline__ XcdBarrier xcd_barrier_post(unsigned* bar, volatile LAS unsigned* st) {
    XcdBarrier b; b.bar = bar; b.x = xb_xcc_id(); b.st = st;
    if (threadIdx.x == 0) (void)xb_add(&bar[XB_XCNT(b.x)], 1u);
    return b;
}
__device__ __forceinline__ void xcd_barrier_complete(unsigned* bar, unsigned x, unsigned& nloc, unsigned& nx) {
    const unsigned G = gridDim.x * gridDim.y * gridDim.z;
    unsigned sum, cnt, mine, sp = 0u;
    for (;;) {
        sum = 0u; cnt = 0u; mine = 0u;
#pragma unroll
        for (unsigned j = 0; j < 16; ++j) { const unsigned c = xb_ld(&bar[XB_XCNT(j)]); sum += c; cnt += (c > 0u) ? 1u : 0u; mine = (j == x) ? c : mine; }
        if (sum == G) break;
        __builtin_amdgcn_s_sleep(1);
        if ((++sp & 255u) == 0u) { if (xb_ld(&bar[XB_TMO])) break; if (sp > XB_SPIN_CAP) { atomicAdd(&bar[XB_TMO], 1u); break; } }
    }
    nloc = mine > 0u ? mine : 1u; nx = cnt > 0u ? cnt : 1u;
}

__device__ __forceinline__ void xcd_barrier(const XcdBarrier& b) {
    asm volatile("s_waitcnt vmcnt(0)" ::: "memory");
    __syncthreads();
    if (threadIdx.x == 0) {
        unsigned* bar = b.bar;
        __builtin_amdgcn_s_waitcnt(0);
        unsigned nloc = b.st[0], nx = b.st[1];
        if (nloc == 0u) { xcd_barrier_complete(bar, b.x, nloc, nx); b.st[0] = nloc; b.st[1] = nx; }
        const unsigned old = xb_add(&bar[XB_XSUB(b.x)], 1u);
        const unsigned gen = old / nloc;
        if (old + 1u == (gen + 1u) * nloc) {
            __builtin_amdgcn_fence(__ATOMIC_RELEASE, "agent");
            asm volatile("s_waitcnt vmcnt(0)" ::: "memory");
            const unsigned og = xb_add(&bar[XB_TOP], 1u);
            const unsigned tg = og / nx;
            if (og + 1u == (tg + 1u) * nx) xb_add(&bar[XB_TOPGEN], 1u);
            else XB_SPIN(xb_ld(&bar[XB_TOPGEN]) == tg, bar);
            __builtin_amdgcn_fence(__ATOMIC_ACQUIRE, "agent");
            xb_add(&bar[XB_XGEN(b.x)], 1u);
            asm volatile("s_waitcnt vmcnt(0)" ::: "memory");
        } else {
            XB_SPIN(xb_ld(&bar[XB_XGEN(b.x)]) == gen, bar);
            __builtin_amdgcn_fence(__ATOMIC_ACQUIRE, "agent");
            asm volatile("s_waitcnt vmcnt(0)" ::: "memory");
        }
    }
    __syncthreads();
}
constexpr int NWAVES = 8;
#ifndef MK_N_LAUNCHES
#define MK_N_LAUNCHES 1
#endif
constexpr int N_PHASES = 10;
constexpr int N_LAUNCHES = MK_N_LAUNCHES;

constexpr int BATCH = 2, SEQ = 8192, D = 1024, CTXL = 256, NEXP = 32, TOPK = 4, DFF = 1024, INW = 4608;
constexpr int M = BATCH * SEQ;
constexpr int MC = BATCH * CTXL;
constexpr float NORM_EPS = 1e-5f;

constexpr size_t MiB = 1u << 20;
constexpr size_t WS_CTL = 0, CTL_ZERO_BYTES = 1 * MiB;
constexpr size_t WS_MOD = 1 * MiB;
constexpr size_t WS_WIN = 2 * MiB, WS_WAB = 11 * MiB, WS_WPL = 13 * MiB, WS_WOUT = 15 * MiB;
constexpr size_t WS_XN = 18 * MiB;
constexpr size_t WS_Q = 52 * MiB, WS_KX = 84 * MiB, WS_VX = 93 * MiB;
constexpr size_t WS_U = 102 * MiB, WS_SA = 134 * MiB, WS_SP = 166 * MiB, WS_AO = 198 * MiB, WS_DIFF = 230 * MiB, WS_MRG = 262 * MiB, WS_H2 = 294 * MiB;
constexpr size_t WS_LIST = 326 * MiB, WS_GW = 328 * MiB;
constexpr size_t WS_WGU = 330 * MiB, WS_WD = 458 * MiB;
constexpr size_t WS_WIN8 = 394 * MiB, WS_XN8 = 400 * MiB;
constexpr size_t WS_ACT = 522 * MiB, WS_Y2 = 666 * MiB, WS_END = 794 * MiB;
constexpr int CW_TMO = 0, CW_CODE = 1;
constexpr int CW_BAR = 4096;
constexpr int CW_ADA = 64;
constexpr int CW_GCNT = 16384;
constexpr int CW_PANEL = 32768;

constexpr int RING_OFF = 0, RING_BYTES = 131072;
constexpr int LDSCTL_OFF = RING_BYTES, MISC_OFF = LDSCTL_OFF + 320;
constexpr int XTRA_OFF = LDSCTL_OFF + 1024;
constexpr int LDS_BYTES = 147456;

__constant__ float ROPE_INVF[16] = {1.0f, 0.5623413324356079f, 0.3162277638912201f, 0.17782793939113617f, 0.10000000149011612f, 0.05623413249850273f, 0.03162277489900589f, 0.017782794311642647f,
    0.009999999776482582f, 0.005623413249850273f, 0.003162277629598975f, 0.0017782794311642647f, 0.0010000000474974513f, 0.000562341301701963f, 0.0003162277571391314f, 0.00017782794020604342f};

struct Frame {
    LAS unsigned char* lds;
    volatile LAS unsigned* MISC;
    gu32* ctl;
    int tid, lane, wave;
    int vcu, G;
    const float *x, *c, *ctx, *c_ctx, *w_ada, *b_ada, *n1g, *n2g, *w_in, *b_in, *sink, *w_pool, *pscale, *w_ab, *w_pb, *w_out, *w_router, *b_router, *w_gu, *b_gu, *w_down, *b_down, *final_g;
    float* out; float* out2; gu32* gcnt;
    float *modx, *modc, *ropec, *ropes, *GW;
    bf16 *Win_t, *Wab_t, *Wpl_t, *Wout_t; unsigned char *Wgu8, *Wd8, *H28, *ACT8, *Win8, *XN8;
    bf16 *XN, *Q, *KX, *VX, *U, *SA, *SP, *AO, *DIFF, *MRG; unsigned char* Y2;
    int* LIST;
};

__device__ __forceinline__ float wave_sum(float v) {
#pragma unroll
    for (int o = 1; o < 64; o <<= 1) v += __shfl_xor(v, o);
    return v;
}
__device__ __forceinline__ float wave_max(float v) {
#pragma unroll
    for (int o = 1; o < 64; o <<= 1) v = fmaxf(v, __shfl_xor(v, o));
    return v;
}
__device__ __forceinline__ int wave_min_i(int v) {
#pragma unroll
    for (int o = 1; o < 64; o <<= 1) { const int t = __shfl_xor(v, o); v = t < v ? t : v; }
    return v;
}
__device__ __forceinline__ void p0_transpose_item(const float* W, int K, int N, bf16* WT, int k0, int n0, int drow0, LAS float* scr, int lane) {
#pragma unroll 8
    for (int i = 0; i < 32; ++i) { const int kk = 2 * i + (lane >> 5); scr[kk * 33 + (lane & 31)] = W[(size_t)(k0 + kk) * N + n0 + (lane & 31)]; }
    LDS_WAIT(); asm volatile("" ::: "memory");
    const int c = lane & 7;
#pragma unroll
    for (int j = 0; j < 4; ++j) { const int n = (lane >> 3) + 8 * j; const LAS float* s = scr + (8 * c) * 33 + n;
        v4u o; o.x = pk2(s[0 * 33], s[1 * 33]); o.y = pk2(s[2 * 33], s[3 * 33]); o.z = pk2(s[4 * 33], s[5 * 33]); o.w = pk2(s[6 * 33], s[7 * 33]);
        *(GAS v4u*)(WT + (size_t)(drow0 + n) * K + k0 + 8 * c) = o; }
    LDS_WAIT(); asm volatile("" ::: "memory");
}
__device__ __forceinline__ float fsilu(float v) { return v / (1.0f + __expf(-v)); }

constexpr int CVT_NITEMS = 16 * 144 + 16 * 32 + 16 * 32 + 32 * 16 * 64 + 32 * 16 * 32;
#ifndef CVT_SLOT2
#define CVT_SLOT2 19456
#endif
#ifndef CVT_G8
#define CVT_G8 180
#endif
#ifndef CVT_G3
#define CVT_G3 205
#endif
#ifndef CVT_SLOT3
#define CVT_SLOT3 13056
#endif
#ifndef CVT_SLOT7
#define CVT_SLOT7 6000
#endif
__device__ __forceinline__ void convert_items(Frame& F, int it0, int itend, int istride) {
    const int lane = F.lane;
    LAS float* scr = (LAS float*)(F.lds + RING_OFF + F.wave * 16384);
    constexpr int I_IN = 16 * 144, I_AB = 16 * 32, I_OUT = 16 * 32, I_GU = 32 * 16 * 64, I_D = 32 * 16 * 32;
    constexpr int NITEMS = I_IN + I_AB + I_OUT + I_GU + I_D;
#define P0_DECODE(it_, SRC, DST, NN, F8) do { int r = (it_); F8 = 0; \
        if (r < I_IN) { const int kb = r / 144, nb = r % 144, n0_ = 32 * nb; NN = INW; SRC = F.w_in + (size_t)(64 * kb) * INW + n0_;   \
            if (n0_ >= 1536 && n0_ < 2560) { DST = (unsigned char*)(F.Win_t + (size_t)n0_ * 1024 + 64 * kb); } else { F8 = 1; DST = F.Win8 + (size_t)n0_ * 1024 + 64 * kb; } break; } r -= I_IN; \
        if (r < I_AB) { const int kb = r / 32, nb = r % 32; NN = 1024; SRC = F.w_ab + (size_t)(64 * kb) * 1024 + 32 * nb; DST = (unsigned char*)(F.Wab_t + (size_t)(32 * nb) * 1024 + 64 * kb); break; } r -= I_AB; \
        if (r < I_OUT) { const int kb = r / 32, nb = r % 32; NN = 1024; SRC = F.w_out + (size_t)(64 * kb) * 1024 + 32 * nb; F8 = 1; DST = (unsigned char*)F.Wout_t + (size_t)(32 * nb) * 1024 + 64 * kb; break; }     r -= I_OUT; \
        F8 = 1; \
        if (r < I_GU) { const int e = r >> 10, rr = r & 1023, kb = rr >> 6, nb = rr & 63; const int n0 = 32 * nb; \
            const int d0 = (n0 < 1024) ? (256 * (n0 >> 7) + (n0 & 127)) : (256 * ((n0 - 1024) >> 7) + 128 + ((n0 - 1024) & 127));   \
            NN = 2048; SRC = F.w_gu + (size_t)e * 1024 * 2048 + (size_t)(64 * kb) * 2048 + n0; DST = F.Wgu8 + (size_t)e * 2048 * 1024 + (size_t)d0 * 1024 + 64 * kb; break; } r -= I_GU; \
        { const int e = r >> 9, rr = r & 511, kb = rr >> 5, nb = rr & 31; NN = 1024; SRC = F.w_down + (size_t)e * 1024 * 1024 + (size_t)(64 * kb) * 1024 + 32 * nb; DST = F.Wd8 + (size_t)e * 1024 * 1024 + (size_t)(32 * nb) * 1024 + 64 * kb; } } while (0)
#ifdef P0_NT_ST
#define P0_ST(p, v) __builtin_nontemporal_store((v), (p))
#else
#define P0_ST(p, v) (*(p) = (v))
#endif
#ifndef P0_NO_NT
#define P0_LD(p) __builtin_nontemporal_load(p)
#define P0_LD4(p) __builtin_nontemporal_load(p)
#else
#define P0_LD(p) (*(p))
#define P0_LD4(p) (*(p))
#endif
    {
        int it = it0; const float* src = nullptr; unsigned char* dst = nullptr; int NN = 0, f8 = 0; float v[32];
        if (it < itend) { P0_DECODE(it, src, dst, NN, f8);
#pragma unroll
            for (int i = 0; i < 8; ++i) { const f32x4 q_ = P0_LD4((const GAS f32x4*)(src + (size_t)(8 * i + (lane >> 3)) * NN + 4 * (lane & 7))); v[4 * i] = q_.x; v[4 * i + 1] = q_.y; v[4 * i + 2] = q_.z; v[4 * i + 3] = q_.w; } }
        while (it < itend) {
#pragma unroll
            for (int i = 0; i < 32; ++i) scr[(8 * (i >> 2) + (lane >> 3)) * 33 + 4 * (lane & 7) + (i & 3)] = v[i];
            unsigned char* cdst = dst; const int cf8 = f8; it += istride;
            if (it < itend) { P0_DECODE(it, src, dst, NN, f8);
#pragma unroll
                for (int i = 0; i < 8; ++i) { const f32x4 q_ = P0_LD4((const GAS f32x4*)(src + (size_t)(8 * i + (lane >> 3)) * NN + 4 * (lane & 7))); v[4 * i] = q_.x; v[4 * i + 1] = q_.y; v[4 * i + 2] = q_.z; v[4 * i + 3] = q_.w; } }
            LDS_WAIT(); asm volatile("" ::: "memory");
            if (cf8) {
                const int c = lane & 3;
#pragma unroll
                for (int j = 0; j < 2; ++j) { const int n = (lane >> 2) + 16 * j; const LAS float* sp = scr + (16 * c) * 33 + n;
                    v4u o;
                    o.x = pk4_fp8(MOE_WSCALE * sp[0 * 33], MOE_WSCALE * sp[1 * 33], MOE_WSCALE * sp[2 * 33], MOE_WSCALE * sp[3 * 33]); o.y = pk4_fp8(MOE_WSCALE * sp[4 * 33], MOE_WSCALE * sp[5 * 33], MOE_WSCALE * sp[6 * 33], MOE_WSCALE * sp[7 * 33]);
                    o.z = pk4_fp8(MOE_WSCALE * sp[8 * 33], MOE_WSCALE * sp[9 * 33], MOE_WSCALE * sp[10 * 33], MOE_WSCALE * sp[11 * 33]); o.w = pk4_fp8(MOE_WSCALE * sp[12 * 33], MOE_WSCALE * sp[13 * 33], MOE_WSCALE * sp[14 * 33], MOE_WSCALE * sp[15 * 33]);
                    P0_ST((GAS v4u*)(cdst + (size_t)n * 1024 + 16 * c), o); }
            } else {
                const int c = lane & 7;
#pragma unroll
                for (int j = 0; j < 4; ++j) { const int n = (lane >> 3) + 8 * j; const LAS float* sp = scr + (8 * c) * 33 + n;
                    v4u o; o.x = pk2(sp[0 * 33], sp[1 * 33]); o.y = pk2(sp[2 * 33], sp[3 * 33]); o.z = pk2(sp[4 * 33], sp[5 * 33]); o.w = pk2(sp[6 * 33], sp[7 * 33]);
                    P0_ST((GAS v4u*)((bf16*)cdst + (size_t)n * 1024 + 8 * c), o); }
            }
            LDS_WAIT(); asm volatile("" ::: "memory");
        }
    }
#undef P0_DECODE
}
__device__ __forceinline__ void pool_fold(Frame& F, int gt0, int gts);
__device__ __forceinline__ void p0_prologue(Frame& F) {
    const int gw = F.vcu * NWAVES + F.wave, NGW = F.G * NWAVES, lane = F.lane;
#ifdef ADA_REP
    for (int rep2_ = 0; rep2_ < 2; ++rep2_)
#endif
    for (int it = gw; it < 1536; it += NGW) {
        const int n0 = 4 * it; const bool wantc = n0 < 2048;
        f32x4 a0 = {0.f, 0.f, 0.f, 0.f}, a1 = a0, a2 = a0;
#pragma unroll 4
        for (int j = 0; j < 16; ++j) { const int k = lane + 64 * j;
            const f32x4 w = *(const GAS f32x4*)(F.w_ada + (size_t)k * 6144 + n0);
            a0 += fsilu(F.c[k]) * w; a1 += fsilu(F.c[1024 + k]) * w; a2 += fsilu(F.c_ctx[k]) * w; }
#pragma unroll
        for (int i = 0; i < 4; ++i) { a0[i] = wave_sum(a0[i]); a1[i] = wave_sum(a1[i]); a2[i] = wave_sum(a2[i]); }
        if (lane == 0) { const f32x4 bb = *(const f32x4*)(F.b_ada + n0);
            const f32x4 r0 = a0 + bb, r1 = a1 + bb, r2 = a2 + bb;
#define ST8(p, lo_, hi_) __hip_atomic_store((gu64*)(p), ((unsigned long long)__float_as_uint(hi_) << 32) | __float_as_uint(lo_), RLX_AGENT)
            ST8(F.modx + n0, r0.x, r0.y); ST8(F.modx + n0 + 2, r0.z, r0.w); ST8(F.modx + 6144 + n0, r1.x, r1.y); ST8(F.modx + 6144 + n0 + 2, r1.z, r1.w);
            if (wantc) { ST8(F.modc + n0, r2.x, r2.y); ST8(F.modc + n0 + 2, r2.z, r2.w); }
#undef ST8
            asm volatile("s_waitcnt vmcnt(0)" ::: "memory");
            __hip_atomic_fetch_add(F.ctl + CW_ADA, 1u, RLX_AGENT); }
    }
    {
        for (int idx = gw * 64 + lane; idx < 3072; idx += NGW * 64) {
            const int ti = idx >> 4, p = idx & 15; const float pos = (float)(ti < 128 ? ti : ti - 128);
            const float angf = pos * ROPE_INVF[p];
            const double a = (double)angf; const double n = __builtin_rint(a * 0.63661977236758134308); const double r = __builtin_fma(-n, 6.123233995736766e-17, __builtin_fma(-n, 1.5707963267948966, a));
            const double r2 = r * r;
            double sp = -7.6471637318198164759e-13; sp = sp * r2 + 1.6059043836821614599e-10; sp = sp * r2 - 2.5052108385441718775e-8; sp = sp * r2 + 2.7557319223985890653e-6; sp = sp * r2 - 1.9841269841269841270e-4; sp = sp * r2 + 8.3333333333333333333e-3; sp = sp * r2 - 1.6666666666666666667e-1; const double sn = r + r * r2 * sp;
            double cp = 4.7794773323873852974e-14; cp = cp * r2 - 1.1470745597729724714e-11; cp = cp * r2 + 2.0876756987868098979e-9; cp = cp * r2 - 2.7557319223985890653e-7; cp = cp * r2 + 2.4801587301587301587e-5; cp = cp * r2 - 1.3888888888888888889e-3; cp = cp * r2 + 4.1666666666666666667e-2; cp = cp * r2 - 0.5; const double cs = 1.0 + r2 * cp;
            const int q = ((int)n) & 3; double co, si;
            if (q == 0) { co = cs; si = sn; } else if (q == 1) { co = -sn; si = cs; } else if (q == 2) { co = -cs; si = -sn; } else { co = sn; si = -cs; }
            F.ropec[idx] = (float)co; F.ropes[idx] = (float)si;
        }
    }
    convert_items(F, gw, CVT_NITEMS - CVT_SLOT2 - CVT_SLOT7 - CVT_SLOT3, NGW);
#ifdef CVT_REP
    convert_items(F, gw, CVT_NITEMS - CVT_SLOT2 - CVT_SLOT7 - CVT_SLOT3, NGW);
#endif
    pool_fold(F, F.vcu * (NWAVES * 64) + F.tid, F.G * NWAVES * 64);
#ifdef FOLD_REP
    pool_fold(F, F.vcu * (NWAVES * 64) + F.tid, F.G * NWAVES * 64);
#endif
#ifdef STRIDE_PROBE
    {
        float accd = 0.f;
        for (int it = gw; it < 32 * 1024; it += NGW) { const int e = it >> 10, rr = it & 1023, kb = rr >> 6, nb = rr & 63;
            const float* src = F.w_gu + (size_t)e * 1024 * 2048 + (size_t)(64 * kb) * 2048 + 32 * nb; float v[32];
#pragma unroll
            for (int i = 0; i < 32; ++i) v[i] = __builtin_nontemporal_load(src + (size_t)(2 * i + (lane >> 5)) * 2048 + (lane & 31));
#pragma unroll
            for (int i = 0; i < 32; ++i) accd += v[i]; }
        if (accd == 1234.5f) F.GW[0] = 1.f;
    }
#endif
#ifdef STREAM_PROBE
    {
        const GAS f32x4* p = (const GAS f32x4*)F.w_gu; f32x4 acc4 = {0.f, 0.f, 0.f, 0.f};
        for (size_t i = (size_t)(F.vcu * NWAVES + F.wave) * 64 + lane; i < (size_t)32 * 1024 * 2048 / 4; i += (size_t)F.G * NWAVES * 64 * 4) {
            const f32x4 v0 = __builtin_nontemporal_load(p + i), v1 = __builtin_nontemporal_load(p + i + (size_t)F.G * NWAVES * 64), v2 = __builtin_nontemporal_load(p + i + (size_t)F.G * NWAVES * 128), v3 = __builtin_nontemporal_load(p + i + (size_t)F.G * NWAVES * 192);
            acc4 += v0 + v1 + v2 + v3; }
        if (acc4.x + acc4.y + acc4.z + acc4.w == 1234.5f) F.GW[0] = 1.f;
    }
#endif
}
__device__ __forceinline__ void pool_fold(Frame& F, int gt0, int gts) {
    LAS float* wl = (LAS float*)(F.lds + RING_OFF + F.wave * 16384);
    const int lane = F.lane;
    for (int gt = gt0; gt < 1024 * 128; gt += gts) {
        const int n = gt & 1023, kg = __builtin_amdgcn_readfirstlane(gt >> 10), k0 = 8 * kg, g = k0 >> 8;
        const float* wp = F.w_pool + (size_t)k0 * 256;
#pragma unroll
        for (int q = 0; q < 8; ++q) *(LAS f32x4*)(wl + 4 * (lane + 64 * q)) = *(const GAS f32x4*)(wp + 4 * (lane + 64 * q));
        LDS_WAIT(); asm volatile("" ::: "memory");
        float a[8];
#pragma unroll
        for (int i = 0; i < 8; ++i) a[i] = 0.f;
#pragma unroll 2
        for (int j4 = 0; j4 < 64; ++j4) {
            float bsc[4];
#pragma unroll
            for (int jj = 0; jj < 4; ++jj) bsc[jj] = F.pscale[256 * g + 4 * j4 + jj] * F.w_pb[(size_t)(256 * g + 4 * j4 + jj) * 1024 + n];
#pragma unroll
            for (int i = 0; i < 8; ++i) { const f32x4 w = *(const LAS f32x4*)(wl + i * 256 + 4 * j4); a[i] += (w.x * bsc[0] + w.y * bsc[1]) + (w.z * bsc[2] + w.w * bsc[3]); }
        }
        v4u o; o.x = pk2(a[0], a[1]); o.y = pk2(a[2], a[3]); o.z = pk2(a[4], a[5]); o.w = pk2(a[6], a[7]);
        *(GAS v4u*)(F.Wpl_t + (size_t)n * 1024 + k0) = o;
        LDS_WAIT(); asm volatile("" ::: "memory");
    }
}
__device__ __forceinline__ void p1_row(Frame& F, int m, const f32x4 (&v)[4], int lane) {
    const float *sh, *sc;
    if (m < M) { sh = F.modx + (m >> 13) * 6144; sc = sh + 1024; } else { sh = F.modc; sc = F.modc + 1024; }
    float s = 0.f;
#pragma unroll
    for (int j = 0; j < 4; ++j) s += (v[j].x * v[j].x + v[j].y * v[j].y) + (v[j].z * v[j].z + v[j].w * v[j].w);
    const float rstd = 1.0f / sqrtf(wave_sum(s) * (1.f / D) + NORM_EPS);
    GAS unsigned long long* o8 = (GAS unsigned long long*)(F.XN + (size_t)m * D) + lane; GAS unsigned* o4 = (GAS unsigned*)(F.XN8 + (size_t)m * D) + lane;
#pragma unroll
    for (int j = 0; j < 4; ++j) { const int c0 = 4 * lane + 256 * j;
        const f32x4 g = *(const f32x4*)(F.n1g + c0), a = *(const f32x4*)(sc + c0), h = *(const f32x4*)(sh + c0);
        const f32x4 y = (v[j] * rstd) * g * (a + 1.0f) + h;
        if (m < M) o8[64 * j] = (unsigned long long)pk2(y.x, y.y) | ((unsigned long long)pk2(y.z, y.w) << 32);
        o4[64 * j] = pk4_fp8(y.x, y.y, y.z, y.w); }
}
__device__ __forceinline__ void p1_norm_mod(Frame& F, bool wait_ada) {
    const int gw = F.vcu * NWAVES + F.wave, NGW = F.G * NWAVES, lane = F.lane;
    if (wait_ada) {
        unsigned sp = 0; while (__hip_atomic_load(F.ctl + CW_ADA, RLX_AGENT) < 1536u) { __builtin_amdgcn_s_sleep(2); if (++sp > (1u << 22)) break; }
        __builtin_amdgcn_fence(__ATOMIC_ACQUIRE, "agent"); asm volatile("s_waitcnt vmcnt(0)" ::: "memory");
    }
    for (int m = gw; m < M + MC; m += 2 * NGW) {
        const int m2 = m + NGW; const bool two = m2 < M + MC;
        const float* r1 = (m < M) ? F.x + (size_t)m * D : F.ctx + (size_t)(m - M) * D;
        const float* r2 = !two ? r1 : ((m2 < M) ? F.x + (size_t)m2 * D : F.ctx + (size_t)(m2 - M) * D);
        f32x4 v1[4], v2[4];
#pragma unroll
        for (int j = 0; j < 4; ++j) v1[j] = ((const GAS f32x4*)r1 + lane)[64 * j];
#pragma unroll
        for (int j = 0; j < 4; ++j) v2[j] = ((const GAS f32x4*)r2 + lane)[64 * j];
        p1_row(F, m, v1, lane);
        if (two) p1_row(F, m2, v2, lane);
    }
}
template <int G_> __device__ __forceinline__ void pool_item(Frame& F, int m, int chunk) {
    constexpr int half = 1 << G_, W = 2 * half;
    const int l = m & (SEQ - 1);
    const bf16* base = F.U + (size_t)(m - l) * D + G_ * 256 + chunk * 8;
    v4u w[W];
#pragma unroll
    for (int i = 0; i < W; ++i) { int j = l - half + i; j = j < 0 ? 0 : (j > SEQ - 1 ? SEQ - 1 : j); w[i] = *(const GAS v4u*)(base + (size_t)j * D); }
    float s[8];
#pragma unroll
    for (int i = 0; i < 8; ++i) s[i] = 0.f;
    int cnt = 0;
#pragma unroll
    for (int i = 0; i < W; ++i) { const bool ok = (unsigned)(l - half + i) < (unsigned)SEQ; const float f = ok ? 1.f : 0.f; cnt += ok ? 1 : 0;
        s[0] += f * bflo(w[i].x); s[1] += f * bfhi(w[i].x); s[2] += f * bflo(w[i].y); s[3] += f * bfhi(w[i].y); s[4] += f * bflo(w[i].z); s[5] += f * bfhi(w[i].z); s[6] += f * bflo(w[i].w); s[7] += f * bfhi(w[i].w); }
    const v4u c = w[half]; const float inv = 1.0f / (float)cnt;
    v4u o; o.x = pk2(s[0] * inv - bflo(c.x), s[1] * inv - bfhi(c.x)); o.y = pk2(s[2] * inv - bflo(c.y), s[3] * inv - bfhi(c.y)); o.z = pk2(s[4] * inv - bflo(c.z), s[5] * inv - bfhi(c.z)); o.w = pk2(s[6] * inv - bflo(c.w), s[7] * inv - bfhi(c.w));
    *(GAS v4u*)(F.DIFF + (size_t)m * D + G_ * 256 + chunk * 8) = o;
}
__device__ __forceinline__ void p3_pool_diff(Frame& F) {
    const int gw = F.vcu * NWAVES + F.wave, NGW = F.G * NWAVES;
    for (int wi = gw; wi < 4 * (M / 2); wi += NGW) {
        const int g = (wi + (wi >> 11)) & 3, m = 2 * (wi >> 2) + (F.lane >> 5), chunk = F.lane & 31;
        if (g == 0) pool_item<0>(F, m, chunk); else if (g == 1) pool_item<1>(F, m, chunk); else if (g == 2) pool_item<2>(F, m, chunk); else pool_item<3>(F, m, chunk);
    }
}
typedef short p6_bf16x8 __attribute__((ext_vector_type(8)));
__device__ __forceinline__ float half_max(float v) {
#pragma unroll
    for (int o = 1; o < 32; o <<= 1) v = fmaxf(v, __shfl_xor(v, o));
    return v;
}
__device__ __forceinline__ int half_min_i(int v) {
#pragma unroll
    for (int o = 1; o < 32; o <<= 1) { const int t = __shfl_xor(v, o); v = t < v ? t : v; }
    return v;
}
__device__ __forceinline__ f32x4 p6_x1(Frame& F, int row, int lane, int j) {
    const f32x4 xv = ((const GAS f32x4*)(F.x + (size_t)row * D) + lane)[64 * j]; const unsigned long long d = ((const GAS unsigned long long*)(F.XN + (size_t)row * D) + lane)[64 * j];
    return xv + (f32x4){bflo((unsigned)d), bfhi((unsigned)d), bflo((unsigned)(d >> 32)), bfhi((unsigned)(d >> 32))};
}
__device__ __forceinline__ void panel_wait(Frame& F, int bank, int pm);
__device__ __forceinline__ void p6_router(Frame& F, bool wait_panel) {
    LAS unsigned char* SH = F.lds + RING_OFF;
    LAS unsigned char* SL = SH + 32768;
    LAS float* PP = (LAS float*)(SH + 65536);
    volatile LAS int* CNTL = (volatile LAS int*)(F.lds + XTRA_OFF + 384); volatile LAS int* BASEL = CNTL + 32; volatile LAS int* ENT = CNTL + 64;
    const int tid = F.tid, lane = F.lane, wave = F.wave;
    const int tk = lane & 15, kq = lane >> 4;
    p6_bf16x8 Bh[4][2], Bl[4][2];
#pragma unroll
    for (int s = 0; s < 4; ++s)
#pragma unroll
        for (int eh = 0; eh < 2; ++eh) {
            unsigned hw[4], lw[4];
#pragma unroll
            for (int jj = 0; jj < 4; ++jj) {
                const int k = 128 * wave + 32 * s + 8 * kq + 2 * jj;
                const float w0 = F.w_router[(size_t)k * 32 + 16 * eh + tk], w1 = F.w_router[(size_t)(k + 1) * 32 + 16 * eh + tk];
                const unsigned h = pk2(w0, w1); hw[jj] = h; lw[jj] = pk2(w0 - bflo(h), w1 - bfhi(h));
            }
            Bh[s][eh] = __builtin_bit_cast(p6_bf16x8, (v4u){hw[0], hw[1], hw[2], hw[3]}); Bl[s][eh] = __builtin_bit_cast(p6_bf16x8, (v4u){lw[0], lw[1], lw[2], lw[3]});
        }
    const float brt = F.b_router[lane & 31];
    for (int rb = F.vcu; rb < M / 64; rb += F.G) {
        if (wait_panel) panel_wait(F, 1, rb >> 2);
        if (tid < 32) CNTL[tid] = 0;
        const int b = (rb * 64) >> 13;
        f32x4 gs[4], hs[4];
        { const float* sh = F.modx + b * 6144 + 3072; const float* sc = sh + 1024;
#pragma unroll
          for (int j = 0; j < 4; ++j) { const int c0 = 4 * lane + 256 * j; gs[j] = *(const f32x4*)(F.n2g + c0) * (*(const f32x4*)(sc + c0) + 1.0f); hs[j] = *(const f32x4*)(sh + c0); } }
        f32x4 nx[2][4];
#pragma unroll
        for (int r = 0; r < 2; ++r)
#pragma unroll
            for (int j = 0; j < 4; ++j) nx[r][j] = p6_x1(F, rb * 64 + 2 * wave + r, lane, j);
#pragma unroll 1
        for (int tg = 0; tg < 4; ++tg) {
#pragma unroll
            for (int r = 0; r < 2; ++r) {
                const int trow = 2 * wave + r, row = rb * 64 + tg * 16 + trow;
                f32x4 h[4]; float ssq = 0.f;
#pragma unroll
                for (int j = 0; j < 4; ++j) { h[j] = nx[r][j]; ssq += (h[j].x * h[j].x + h[j].y * h[j].y) + (h[j].z * h[j].z + h[j].w * h[j].w); }
                if (tg < 3) {
#pragma unroll
                    for (int j = 0; j < 4; ++j) nx[r][j] = p6_x1(F, row + 16, lane, j);
                }
                const float rstd = 1.0f / sqrtf(wave_sum(ssq) * (1.f / D) + NORM_EPS);
                GAS unsigned* o4 = (GAS unsigned*)(F.H28 + (size_t)row * D) + lane;
#pragma unroll
                for (int j = 0; j < 4; ++j) {
                    h[j] = (h[j] * rstd) * gs[j] + hs[j];
                    o4[64 * j] = pk4_fp8(h[j].x, h[j].y, h[j].z, h[j].w);
                    const unsigned h01 = pk2(h[j].x, h[j].y), h23 = pk2(h[j].z, h[j].w);
                    const unsigned l01 = pk2(h[j].x - bflo(h01), h[j].y - bfhi(h01)), l23 = pk2(h[j].z - bflo(h23), h[j].w - bfhi(h23));
                    const int k = 4 * lane + 256 * j, c = k >> 3, off = trow * 2048 + ((c ^ trow) << 4) + ((k >> 2) & 1) * 8;
                    *(LAS unsigned long long*)(SH + off) = (unsigned long long)h01 | ((unsigned long long)h23 << 32);
                    *(LAS unsigned long long*)(SL + off) = (unsigned long long)l01 | ((unsigned long long)l23 << 32);
                }
            }
            __syncthreads();
            f32x4 a0 = {0.f, 0.f, 0.f, 0.f}, a1 = a0;
#pragma unroll
            for (int s = 0; s < 4; ++s) {
                const int c = 16 * wave + 4 * s + kq, off = tk * 2048 + ((c ^ tk) << 4);
                const p6_bf16x8 ah = *(const LAS p6_bf16x8*)(SH + off), al = *(const LAS p6_bf16x8*)(SL + off);
                a0 = __builtin_amdgcn_mfma_f32_16x16x32_bf16(ah, Bh[s][0], a0, 0, 0, 0); a0 = __builtin_amdgcn_mfma_f32_16x16x32_bf16(ah, Bl[s][0], a0, 0, 0, 0); a0 = __builtin_amdgcn_mfma_f32_16x16x32_bf16(al, Bh[s][0], a0, 0, 0, 0);
                a1 = __builtin_amdgcn_mfma_f32_16x16x32_bf16(ah, Bh[s][1], a1, 0, 0, 0); a1 = __builtin_amdgcn_mfma_f32_16x16x32_bf16(ah, Bl[s][1], a1, 0, 0, 0); a1 = __builtin_amdgcn_mfma_f32_16x16x32_bf16(al, Bh[s][1], a1, 0, 0, 0);
            }
#pragma unroll
            for (int r = 0; r < 4; ++r) { PP[(wave * 16 + 4 * kq + r) * 32 + tk] = a0[r]; PP[(wave * 16 + 4 * kq + r) * 32 + 16 + tk] = a1[r]; }
            __syncthreads();
            {
                const int trow = 2 * wave + (lane >> 5), e = lane & 31, row = rb * 64 + tg * 16 + trow, rl = tg * 16 + trow;
                float logit = brt;
#pragma unroll
                for (int v = 0; v < 8; ++v) logit += PP[(v * 16 + trow) * 32 + e];
                float tv[4]; int te[4];
#pragma unroll
                for (int k = 0; k < 4; ++k) { const float mx = half_max(logit); const int ix = half_min_i(logit == mx ? e : 99); tv[k] = mx; te[k] = ix; if (e == ix) logit = -INFINITY; }
                const float e1 = __expf(tv[1] - tv[0]), e2 = __expf(tv[2] - tv[0]), e3 = __expf(tv[3] - tv[0]); const float inv = 1.0f / (1.0f + e1 + e2 + e3);
                if (e < 4) { const float wk = (e == 0 ? 1.0f : e == 1 ? e1 : e == 2 ? e2 : e3) * inv; const int ek = e == 0 ? te[0] : e == 1 ? te[1] : e == 2 ? te[2] : te[3];
                    F.GW[(size_t)row * 4 + e] = wk;
                    const int ls = __hip_atomic_fetch_add((LAS int*)&CNTL[ek], 1, __ATOMIC_RELAXED, __HIP_MEMORY_SCOPE_WORKGROUP);
                    ENT[rl * 4 + e] = (ek << 16) | ls; }
            }
            __syncthreads();
        }
        if (tid < 32) BASEL[tid] = (int)__hip_atomic_fetch_add(F.gcnt + 64 * tid, (unsigned)CNTL[tid], __ATOMIC_RELAXED, __HIP_MEMORY_SCOPE_AGENT);
        __syncthreads();
        if (tid < 256) { const int en = ENT[tid], e = en >> 16, ls = en & 0xffff; F.LIST[e * 16384 + BASEL[e] + ls] = (rb * 64 + (tid >> 2)) * 4 + (tid & 3); }
        __syncthreads();
    }
}
__device__ __forceinline__ void moe_prefix(Frame& F) {
    volatile LAS int* PT = (volatile LAS int*)(F.lds + XTRA_OFF); volatile LAS int* CN = PT + 64;
    if (F.tid == 0) { int acc = 0; for (int e = 0; e < 32; ++e) { const int c = (int)__hip_atomic_load(F.gcnt + 64 * e, RLX_AGENT); CN[e] = c; PT[e] = acc; acc += (c + 255) >> 8; } PT[32] = acc; }
    __syncthreads();
}
__device__ __forceinline__ void p9_final(Frame& F) {
    const int gw = F.vcu * NWAVES + F.wave, NGW = F.G * NWAVES, lane = F.lane;
    for (int m = gw; m < M; m += NGW) {
        const float* g2 = F.modx + (m >> 13) * 6144 + 5120;
        const f32x4 gwv = *(const f32x4*)(F.GW + (size_t)m * 4);
        f32x4 v[4]; float s = 0.f;
#pragma unroll
        for (int j = 0; j < 4; ++j) {
            f32x4 y = {0.f, 0.f, 0.f, 0.f};
#pragma unroll
            for (int k = 0; k < 4; ++k) { const int w = *((const GAS int*)(F.Y2 + ((size_t)m * 4 + k) * D) + lane + 64 * j);
                const float gk = gwv[k] * (1.0f / Y2_SCALE); y.x += gk * __builtin_amdgcn_cvt_f32_fp8(w, 0); y.y += gk * __builtin_amdgcn_cvt_f32_fp8(w, 1); y.z += gk * __builtin_amdgcn_cvt_f32_fp8(w, 2); y.w += gk * __builtin_amdgcn_cvt_f32_fp8(w, 3); }
            const f32x4 g = *(const f32x4*)(g2 + 4 * lane + 256 * j);
            v[j] = p6_x1(F, m, lane, j) + g * y; s += (v[j].x * v[j].x + v[j].y * v[j].y) + (v[j].z * v[j].z + v[j].w * v[j].w);
        }
        const float rstd = 1.0f / sqrtf(wave_sum(s) * (1.f / D) + NORM_EPS);
#pragma unroll
        for (int j = 0; j < 4; ++j) { const f32x4 g = *(const f32x4*)(F.final_g + 4 * lane + 256 * j); ((GAS f32x4*)(F.out2 + (size_t)m * D) + lane)[64 * j] = (v[j] * rstd) * g; }
    }
}

__device__ __forceinline__ void panel_publish(Frame& F, int bank, int pm) {
    asm volatile("s_waitcnt vmcnt(0)" ::: "memory");
    if (F.lane == 0) __hip_atomic_fetch_add(F.ctl + CW_PANEL + bank * 8192 + 64 * pm, 1u, RLX_AGENT);
}
__device__ __forceinline__ void panel_wait(Frame& F, int bank, int pm) {
    if (F.wave == 0) { unsigned sp = 0; while ((unsigned)__builtin_amdgcn_readfirstlane((int)__hip_atomic_load(F.ctl + CW_PANEL + bank * 8192 + 64 * pm, RLX_AGENT)) < 32u) { __builtin_amdgcn_s_sleep(2); if (++sp > (1u << 21)) break; }
        __builtin_amdgcn_fence(__ATOMIC_ACQUIRE, "agent"); asm volatile("s_waitcnt vmcnt(0)" ::: "memory"); }
    __syncthreads();
}
struct Args { const float* in[23]; float* out; unsigned char* ws; int ph_lo, ph_hi, probe, pad; };
__global__ void __launch_bounds__(NWAVES * 64, 2) fwd_megakernel(Args args) {
    extern __shared__ __attribute__((aligned(16))) unsigned char lds[];
    Frame F;
    F.lds = (LAS unsigned char*)lds;
    F.MISC = (volatile LAS unsigned*)(F.lds + MISC_OFF);
    F.tid = threadIdx.x; F.lane = F.tid & 63; F.wave = __builtin_amdgcn_readfirstlane(F.tid >> 6);
    F.G = gridDim.x; { const int bx = blockIdx.x; F.vcu = (F.G % 8 == 0) ? (bx % 8) * (F.G / 8) + bx / 8 : bx; }
    unsigned char* ws = args.ws;
    F.ctl = (gu32*)(ws + WS_CTL);
    F.x = args.in[0]; F.c = args.in[1]; F.ctx = args.in[2]; F.c_ctx = args.in[3]; F.w_ada = args.in[4]; F.b_ada = args.in[5]; F.n1g = args.in[6]; F.n2g = args.in[7];
    F.w_in = args.in[8]; F.b_in = args.in[9]; F.sink = args.in[10]; F.w_pool = args.in[11]; F.pscale = args.in[12]; F.w_ab = args.in[13]; F.w_pb = args.in[14]; F.w_out = args.in[15];
    F.w_router = args.in[16]; F.b_router = args.in[17]; F.w_gu = args.in[18]; F.b_gu = args.in[19]; F.w_down = args.in[20]; F.b_down = args.in[21]; F.final_g = args.in[22];
    F.out = args.out; F.out2 = args.out; F.gcnt = F.ctl + CW_GCNT;
    F.modx = (float*)(ws + WS_MOD); F.modc = (float*)(ws + WS_MOD + 49152); F.ropec = (float*)(ws + WS_MOD + 65536); F.ropes = (float*)(ws + WS_MOD + 77824); F.GW = (float*)(ws + WS_GW);
    F.Win_t = (bf16*)(ws + WS_WIN); F.Wab_t = (bf16*)(ws + WS_WAB); F.Wpl_t = (bf16*)(ws + WS_WPL); F.Wout_t = (bf16*)(ws + WS_WOUT); F.Wgu8 = ws + WS_WGU; F.Wd8 = ws + WS_WD; F.H28 = ws + WS_H2; F.ACT8 = ws + WS_ACT; F.Win8 = ws + WS_WIN8; F.XN8 = ws + WS_XN8;
    F.XN = (bf16*)(ws + WS_XN); F.Q = (bf16*)(ws + WS_Q); F.KX = (bf16*)(ws + WS_KX); F.VX = (bf16*)(ws + WS_VX); F.U = (bf16*)(ws + WS_U); F.SA = (bf16*)(ws + WS_SA); F.SP = (bf16*)(ws + WS_SP);
    F.AO = (bf16*)(ws + WS_AO); F.DIFF = (bf16*)(ws + WS_DIFF); F.MRG = (bf16*)(ws + WS_MRG); F.Y2 = ws + WS_Y2;
    F.LIST = (int*)(ws + WS_LIST);
    if (args.probe && args.ph_lo == 6) { F.gcnt = F.ctl + 65536; F.LIST = (int*)(ws + WS_Q); F.GW = (float*)(ws + WS_Q + 4 * MiB); F.H28 = ws + WS_U; }
    if (args.probe && args.ph_lo == 9) { F.out2 = (float*)(ws + WS_Q); }
    for (int u = F.tid; u < (LDS_BYTES - LDSCTL_OFF) / 4; u += NWAVES * 64) ((LAS unsigned*)(F.lds + LDSCTL_OFF))[u] = 0u;
    __syncthreads();
    XcdBarrier bar; bar.bar = (unsigned*)(F.ctl + CW_BAR); bar.x = 0; bar.st = nullptr;
    if (N_LAUNCHES == 1) bar = xcd_barrier_post((unsigned*)(F.ctl + CW_BAR), F.MISC + 8);
#ifdef BAR_REP
#define GRID_BAR() do { if (N_LAUNCHES == 1) { xcd_barrier(bar); xcd_barrier(bar); } } while (0)
#else
#define GRID_BAR() do { if (N_LAUNCHES == 1) { xcd_barrier(bar); } } while (0)
#endif
    const int lo = args.ph_lo, hi = args.ph_hi;
#ifndef PH_MASK
#define PH_MASK 0x3ff
#endif
#define IN(k) (((PH_MASK >> (k)) & 1) && lo <= (k) && (k) < hi)
#define BOTH(k) (IN(k) && IN((k) + 1))
#ifndef REP_MASK
#define REP_MASK 0
#endif
#define REPS(k) for (int rep_ = 0; rep_ < 1 + ((REP_MASK >> (k)) & 1); ++rep_)
#ifdef TSA
    unsigned long long ts_a = 0, ts_b = 0;
#define TS_MARK(id) do { if ((id) == TSA) ts_a = __builtin_amdgcn_s_memrealtime(); if ((id) == TSB) ts_b = __builtin_amdgcn_s_memrealtime(); } while (0)
#else
#define TS_MARK(id) do {} while (0)
#endif
    TS_MARK(0);
    using namespace pg8;
    if (IN(0)) { REPS(0) p0_prologue(F); } TS_MARK(1);
    if (IN(1)) { REPS(1) p1_norm_mod(F, lo == 0); TS_MARK(2); if (BOTH(1)) GRID_BAR(); } TS_MARK(3);
    if (IN(2)) {
        constexpr int G8 = CVT_G8;
        OrdInProj8 S8{F.G == 256 ? G8 : F.G, (int)blockIdx.x, (const char*)F.XN8, (const char*)F.Win8};
        EpiInProj E8{F.b_in, F.Q, F.KX, F.U, (WS_VX - WS_KX) / 2, (WS_SA - WS_U) / 2, F.ropec, F.ropes, 1.0f / MOE_WSCALE};
        static_assert(WS_SP - WS_SA == WS_SA - WS_U, "U | SA | SP equally spaced");
        REPS(2) gemm_phase<EpiInProj, OrdInProj8, true, false, 1>(F.lds + RING_OFF, 1024, 1024, S8, E8);
        if (F.G == 256) { if ((int)blockIdx.x >= G8) convert_items(F, CVT_NITEMS - CVT_SLOT7 - CVT_SLOT2 + ((int)blockIdx.x - G8) * NWAVES + F.wave, CVT_NITEMS - CVT_SLOT7, (256 - G8) * NWAVES); }
        else convert_items(F, CVT_NITEMS - CVT_SLOT7 - CVT_SLOT2 + (int)blockIdx.x * NWAVES + F.wave, CVT_NITEMS - CVT_SLOT7, F.G * NWAVES);
        __syncthreads();
        TS_MARK(4);
        OrdInProjU SU{F.G, (int)blockIdx.x, (const char*)F.XN, (const char*)F.Win_t};
        EpiInProj EU{F.b_in, F.Q, F.KX, F.U, (WS_VX - WS_KX) / 2, (WS_SA - WS_U) / 2, F.ropec, F.ropes, 1.0f};
        REPS(2) gemm_phase<EpiInProj, OrdInProjU, true, false, 2>(F.lds + RING_OFF, 1024, 1024, SU, EU);
        TS_MARK(5);
        if (BOTH(2)) GRID_BAR();
    }
    TS_MARK(6);
    if (IN(3)) {
        const attn_body::AttnTensors AT{(const attn_body::bf16*)F.Q, (const attn_body::bf16*)F.KX, (const attn_body::bf16*)F.VX, (attn_body::bf16*)F.AO, F.sink};
        constexpr int G3 = CVT_G3; const int na = F.G == 256 ? G3 : F.G;
        const attn_body::StaticOrder S(na, (int)blockIdx.x);
        REPS(3) attn_body::attn_phase<attn_body::StaticOrder>((char*)lds + RING_OFF, AT, S);
        TS_MARK(7);
        if (CVT_SLOT3 > 0) {
            constexpr int s3 = CVT_NITEMS - CVT_SLOT7 - CVT_SLOT2 - CVT_SLOT3;
            if (F.G == 256 && G3 < 256) { if ((int)blockIdx.x >= G3) convert_items(F, s3 + ((int)blockIdx.x - G3) * NWAVES + F.wave, s3 + CVT_SLOT3, (256 - G3) * NWAVES); }
            else convert_items(F, s3 + (int)blockIdx.x * NWAVES + F.wave, s3 + CVT_SLOT3, F.G * NWAVES);
        }
        TS_MARK(8);
        REPS(10) p3_pool_diff(F);
        TS_MARK(9);
        if (BOTH(3)) GRID_BAR();
    }
    TS_MARK(10);
    if (IN(4)) {
        OrdMerge S{F.G, (int)blockIdx.x, (const char*)F.AO, (const char*)F.DIFF, (const char*)F.Wab_t, (const char*)F.Wpl_t};
        EpiMerge E{F.SA, F.SP, (unsigned char*)F.MRG};
#ifndef NO_GATE_TOUCH
        { Unit u0; if (S.next(0, u0)) {
            const unsigned dead = (unsigned)(uintptr_t)F.lds + 144384u + (unsigned)F.wave * 256u; const int wr = F.wave >> 2, wc = F.wave & 3;
#pragma unroll
            for (int j = 0; j < 4; ++j) { const int r = j * 32 + (F.lane >> 1); const unsigned voff = (unsigned)(u0.pm * BM + (r >> 6) * HALF + wr * 64 + (r & 63)) * 2048u + (unsigned)(u0.pn * BM + (F.lane & 1) * HALF + wc * 32) * 2u;
                glds_sv4((const char*)F.SA, voff, dead); glds_sv4((const char*)F.SP, voff, dead); } } }
#endif
        REPS(4) gemm_phase<EpiMerge, OrdMerge, true, false>(F.lds + RING_OFF, 1024, 1024, S, E);
        TS_MARK(11);
        { Unit u0; if (BOTH(4) && N_LAUNCHES == 1 && S.next(0, u0)) panel_publish(F, 0, u0.pm); }
    }
    if (IN(5)) {
        OrdStatic S; S.init(M, D, F.G, (int)blockIdx.x, F.MRG, F.Wout_t, (size_t)256 * 1024); S.nt_ = 8;
        EpiOut E{F.modx, F.XN};
        { Unit u0; if (IN(4) && N_LAUNCHES == 1 && S.next(0, u0)) panel_wait(F, 0, u0.pm); }
        TS_MARK(12);
        REPS(5) gemm_phase<EpiOut, OrdStatic, true, false, 1>(F.lds + RING_OFF, 1024, 1024, S, E);
        TS_MARK(13);
        { Unit u0; if (BOTH(5) && N_LAUNCHES == 1 && S.next(0, u0)) panel_publish(F, 1, u0.pm); }
    }
    if (IN(6)) { p6_router(F, IN(5) && N_LAUNCHES == 1); TS_MARK(14); if (BOTH(6)) GRID_BAR(); } TS_MARK(15);
    if (IN(7)) {
        moe_prefix(F);
        volatile LAS int* PT = (volatile LAS int*)(F.lds + XTRA_OFF);
        const int U7 = (int)PT[32] * 8, rounds7 = (U7 + F.G - 1) / F.G, G7 = rounds7 > 0 ? (U7 + rounds7 - 1) / rounds7 : F.G, nsp = F.G - G7;
        OrdMoe S{G7, (int)blockIdx.x, 8, PT, PT + 64, (const char*)F.H28, (const char*)F.Wgu8, (size_t)2048 * 1024, (size_t)256 * 1024, F.LIST, 1};
        EpiSwiglu E{F.b_gu, F.ACT8};
        REPS(7) gemm_phase<EpiSwiglu, OrdMoe, true, true, 1>(F.lds + RING_OFF, 1024, 1024, S, E);
        TS_MARK(16);
        { constexpr int s0 = CVT_NITEMS - CVT_SLOT7; static_assert(CVT_SLOT7 <= 32 * 16 * 32, "the slot of the expert gate/up phase may only hold w_down items"); const int cap = nsp * NWAVES * 56 < CVT_SLOT7 ? nsp * NWAVES * 56 : CVT_SLOT7;
          if ((int)blockIdx.x >= G7) convert_items(F, s0 + ((int)blockIdx.x - G7) * NWAVES + F.wave, s0 + cap, nsp * NWAVES);
          if (cap < CVT_SLOT7) convert_items(F, s0 + cap + (int)blockIdx.x * NWAVES + F.wave, s0 + CVT_SLOT7, F.G * NWAVES); }
        TS_MARK(17);
        if (BOTH(7)) GRID_BAR();
    }
    TS_MARK(18);
    if (IN(8)) {
        moe_prefix(F);
        volatile LAS int* PT = (volatile LAS int*)(F.lds + XTRA_OFF);
        OrdMoe S{F.G, (int)blockIdx.x, 4, PT, PT + 64, (const char*)F.ACT8, (const char*)F.Wd8, (size_t)1024 * 1024, (size_t)256 * 1024, F.LIST, 0};
        EpiDown E{F.b_down, F.Y2, F.LIST, PT + 64};
        REPS(8) gemm_phase<EpiDown, OrdMoe, true, false, 1>(F.lds + RING_OFF, 1024, 1024, S, E);
        TS_MARK(19);
        if (BOTH(8)) GRID_BAR();
    }
    TS_MARK(20);
    if (IN(9)) { p9_final(F); }
    TS_MARK(21);
#ifdef TSA
#ifndef TSWHO
#define TSWHO -1
#endif
    if (F.tid == 0 && (TSWHO < 0 || (int)blockIdx.x == TSWHO)) { const unsigned long long t_end = __builtin_amdgcn_s_memrealtime() + (unsigned long long)TSK * (ts_b - ts_a); while (__builtin_amdgcn_s_memrealtime() < t_end) __builtin_amdgcn_s_sleep(8); }
#endif
#undef IN
#undef BOTH
#undef GRID_BAR
}

extern "C" void kernel_launch(void* const* d_in, const int* in_sizes, int n_in, void* d_out, int out_size, void* d_ws, size_t ws_size, hipStream_t stream) {
    static int grid = 0;
    if (grid == 0) {
        if (n_in != 23 || in_sizes[0] != M * D || out_size != M * D || ws_size < WS_END) { fprintf(stderr, "kernel_launch: built for 23 inputs, x/out of %d floats, >= %zu bytes of workspace; got n_in %d, in0 %d, out %d, ws %zu; nothing launched\n", M * D, (size_t)WS_END, n_in, n_in > 0 ? in_sizes[0] : -1, out_size, ws_size); grid = -1; return; }
        int dev = 0, cus = 0, per_cu = 0;
        if (hipGetDevice(&dev) != hipSuccess || hipDeviceGetAttribute(&cus, hipDeviceAttributeMultiprocessorCount, dev) != hipSuccess) { fprintf(stderr, "kernel_launch: hipGetDevice / hipDeviceGetAttribute failed\n"); grid = -1; return; }
        if (hipFuncSetAttribute((const void*)fwd_megakernel, hipFuncAttributeMaxDynamicSharedMemorySize, LDS_BYTES) != hipSuccess) { fprintf(stderr, "kernel_launch: hipFuncSetAttribute failed\n"); grid = -1; return; }
        if (hipOccupancyMaxActiveBlocksPerMultiprocessor(&per_cu, (const void*)fwd_megakernel, NWAVES * 64, LDS_BYTES) != hipSuccess || per_cu < 1) { fprintf(stderr, "kernel_launch: occupancy query reports %d workgroups per CU; nothing launched\n", per_cu); (void)hipGetLastError(); grid = -1; return; }
        grid = cus;
        if (grid > 256) grid = 256;
    }
    if (grid < 0) return;
    if (hipMemsetAsync((char*)d_ws + WS_CTL, 0, CTL_ZERO_BYTES, stream) != hipSuccess) { fprintf(stderr, "kernel_launch: hipMemsetAsync failed\n"); return; }
    Args a{};
    for (int i = 0; i < 23; ++i) a.in[i] = (const float*)d_in[i];
    a.out = (float*)d_out; a.ws = (unsigned char*)d_ws;
    for (int li = 0; li < N_LAUNCHES; ++li) {
        a.ph_lo = (N_LAUNCHES == 1) ? 0 : li; a.ph_hi = (N_LAUNCHES == 1) ? N_PHASES : li + 1;
#ifdef PROBE_PHASE
        if (li == PROBE_PHASE) { a.probe = (li == 6 || li == 9) ? 1 : 0; hipLaunchKernelGGL(fwd_megakernel, dim3(grid), dim3(NWAVES * 64), LDS_BYTES, stream, a); a.probe = 0; }
#endif
        hipLaunchKernelGGL(fwd_megakernel, dim3(grid), dim3(NWAVES * 64), LDS_BYTES, stream, a);
        const hipError_t le = hipPeekAtLastError();
        if (le != hipSuccess) { fprintf(stderr, "kernel_launch: launch %d failed: %s\n", li, hipGetErrorName(le)); break; }
    }
}
```

```cpp
#include <hip/hip_runtime.h>
#include <hip/hip_bf16.h>
#include <cstdio>
#include <cstdint>
#include <cmath>

typedef float f32x2_t __attribute__((ext_vector_type(2))); typedef __bf16 bf16x2_t __attribute__((ext_vector_type(2)));
__device__ __forceinline__ unsigned pk2(float lo, float hi) { f32x2_t v = {lo, hi}; bf16x2_t b = __builtin_convertvector(v, bf16x2_t); return __builtin_bit_cast(unsigned, b); }
__device__ __forceinline__ float bflo(unsigned w) { return __uint_as_float(w << 16); }
__device__ __forceinline__ float bfhi(unsigned w) { return __uint_as_float(w & 0xffff0000u); }
__device__ __forceinline__ float fsigmoid(float x) { return __builtin_amdgcn_rcpf(1.0f + __builtin_amdgcn_exp2f(-1.4426950408889634f * x)); }
__device__ __forceinline__ unsigned pk4_fp8(float a, float b, float c, float d) { int w = 0; w = __builtin_amdgcn_cvt_pk_fp8_f32(a, b, w, false); w = __builtin_amdgcn_cvt_pk_fp8_f32(c, d, w, true); return (unsigned)w; }
constexpr float MOE_WSCALE = 64.0f, MOE_ASCALE = 4.0f, Y2_SCALE = 8.0f, MRG_SCALE = 8.0f, PB_ASCALE = 8.0f;
constexpr float ATT_C2 = 0.125f * 1.4426950408889634f;

namespace pg8 {
#define PG8_LAS __attribute__((address_space(3)))
typedef unsigned short bf16_t;
typedef short bf16x8 __attribute__((ext_vector_type(8)));
typedef float f32x4 __attribute__((ext_vector_type(4)));
typedef unsigned u32x4 __attribute__((ext_vector_type(4)));
typedef unsigned u32x2 __attribute__((ext_vector_type(2)));
typedef int i32x4v __attribute__((ext_vector_type(4)));
constexpr int PARK_OFF = 131072 + 1024 + 4096;
constexpr int BM = 256, BK = 64, HALF = 128, HTB = HALF * BK * 2  , STAGE_BYTES = 8 * HTB, NXCD = 8, WGM = 8;

__host__ __device__ __forceinline__ int lds_byte(int r, int c) { return r * 128 + ((((c >> 3) ^ (r >> 1)) & 7) << 4); }
__host__ __device__ __forceinline__ void stage_rc(int b, int& R, int& C) { const int s = b >> 4; R = s >> 3; C = (((s & 7) ^ (R >> 1)) & 7) << 3; }
__host__ __device__ __forceinline__ int perm32(int rho) { const int n = rho >> 4, i = rho & 15; return 8 * (i >> 2) + 4 * n + (i & 3); }

struct Unit { int pm, pn; const char* a; const char* b; int x0, x1; };

__host__ __device__ __forceinline__ int xcd_remap(int wgid, int nwg) { const int q = nwg / NXCD, r = nwg % NXCD, xcd = wgid % NXCD, off = wgid / NXCD; return (xcd < r ? xcd * (q + 1) : r * (q + 1) + (xcd - r) * q) + off; }
__host__ __device__ __forceinline__ void tile_map(int wgid, int nM, int nN, int& pm, int& pn) {
    const int nig = WGM * nN, gid = wgid / nig, fm = gid * WGM, gsz = (nM - fm) < WGM ? (nM - fm) : WGM;
    pm = fm + ((wgid % nig) % gsz); pn = (wgid % nig) / gsz;
}

typedef int i32x8 __attribute__((ext_vector_type(8)));
__device__ __forceinline__ void glds_sv(const char* sbase, unsigned voff, unsigned lds_dst) { unsigned keep;
    asm volatile("s_mov_b32 %0, m0\n\ts_mov_b32 m0, %3\n\ts_nop 0\n\tglobal_load_lds_dwordx4 %1, %2\n\ts_mov_b32 m0, %0" : "=&s"(keep) : "v"(voff), "s"(sbase), "s"(lds_dst) : "memory"); }
__device__ __forceinline__ void glds_sv4(const char* sbase, unsigned voff, unsigned lds_dst) { unsigned keep;
    asm volatile("s_mov_b32 %0, m0\n\ts_mov_b32 m0, %3\n\ts_nop 0\n\tglobal_load_lds_dword %1, %2\n\ts_mov_b32 m0, %0" : "=&s"(keep) : "v"(voff), "s"(sbase), "s"(lds_dst) : "memory"); }
template <int N> __device__ __forceinline__ void wait_vm() { static_assert(N >= 0 && N < 64, "vmcnt is a 6-bit count"); asm volatile("s_waitcnt vmcnt(%0)" :: "n"(N) : "memory"); }
__device__ __forceinline__ int fresh_lane() { int l; asm volatile("v_mbcnt_lo_u32_b32 %0, -1, 0\n\tv_mbcnt_hi_u32_b32 %0, -1, %0" : "=v"(l)); return l; }
#if defined(TSA) && defined(TS_NST)
#define PG8_TS(id) do { if constexpr (Epi::NSTORES == TS_NST && Epi::MAY_KEEP == (TS_KEEP != 0) && GATHER == (TS_GATHER != 0)) { if ((id) == TSA && threadIdx.x == 0) *(volatile PG8_LAS unsigned long long*)(lds + 146432) = __builtin_amdgcn_s_memrealtime(); if ((id) == TSB && threadIdx.x == 0) *(volatile PG8_LAS unsigned long long*)(lds + 146440) = __builtin_amdgcn_s_memrealtime(); } } while (0)
#else
#define PG8_TS(id) do {} while (0)
#endif
template <class Epi, class Sched, bool ALIGN_EPI, bool GATHER, int ES = 2>
__device__ __forceinline__ void gemm_phase(PG8_LAS unsigned char* lds, const int K, const int lda, const Sched& S, const Epi& E) {
    const int tid = threadIdx.x, wid = __builtin_amdgcn_readfirstlane(tid >> 6), lane = tid & 63, wr = wid >> 2, wc = wid & 3, fr = lane & 15, fq = lane >> 4;
    const int nt = (K * ES) / (BK * 2);
    unsigned voffB[2];
#pragma unroll
    for (int i = 0; i < 2; ++i) { int R, C; stage_rc(tid * 16 + i * 8192, R, C); const int Rb = Epi::PERM ? ((R & ~31) + perm32(R & 31)) : R;
        voffB[i] = (unsigned)(Rb * K * ES + C * 2); }
    const size_t kstep = (size_t)(BK * 2);
    const size_t hstepB = (size_t)HALF * K * ES;
    const unsigned ldsb = (unsigned)__builtin_amdgcn_readfirstlane((int)((unsigned)(uintptr_t)lds + (unsigned)wid * 1024u));
    const int aoff = lds_byte(wr * 64 + fr, fq * 8), boff = lds_byte(wc * 32 + fr, fq * 8), aoff1 = lds_byte(wr * 64 + fr, 32 + fq * 8), boff1 = lds_byte(wc * 32 + fr, 32 + fq * 8);
#define PG8_SA(b, h) (((b) * 2 + (h)) * HTB)
#define PG8_SB(b, h) ((4 + (b) * 2 + (h)) * HTB)
#define PG8_STAGE(bufoff, gbase, v0, v1) do { glds_sv((const char*)(gbase), (v0), ldsb + (unsigned)(bufoff)); glds_sv((const char*)(gbase), (v1), ldsb + (unsigned)(bufoff) + 8192u); } while (0)
#define PG8_LD8(dst8, off0_, off1_) do { const i32x4v lo_ = *(const PG8_LAS i32x4v*)(lds + (off0_)); const i32x4v hi_ = *(const PG8_LAS i32x4v*)(lds + (off1_)); dst8 = __builtin_shufflevector(lo_, hi_, 0, 1, 2, 3, 4, 5, 6, 7); } while (0)
#define PG8_LDA(dst, b, h) do { _Pragma("unroll") for (int m = 0; m < 4; ++m) { if constexpr (ES == 2) { dst[m][0] = *(const PG8_LAS bf16x8*)(lds + PG8_SA(b, h) + aoff + m * 2048); dst[m][1] = *(const PG8_LAS bf16x8*)(lds + PG8_SA(b, h) + aoff1 + m * 2048); } \
        else { PG8_LD8(dst##8[m], PG8_SA(b, h) + aoff + m * 2048, PG8_SA(b, h) + aoff1 + m * 2048); } } } while (0)
#define PG8_LDB(dst, b, h) do { _Pragma("unroll") for (int n = 0; n < 2; ++n) { if constexpr (ES == 2) { dst[n][0] = *(const PG8_LAS bf16x8*)(lds + PG8_SB(b, h) + boff + n * 2048); dst[n][1] = *(const PG8_LAS bf16x8*)(lds + PG8_SB(b, h) + boff1 + n * 2048); } \
        else { PG8_LD8(dst##8[n], PG8_SB(b, h) + boff + n * 2048, PG8_SB(b, h) + boff1 + n * 2048); } } } while (0)
#define PG8_MMA(ai, bj, At, Bt) do { __builtin_amdgcn_s_setprio(1); _Pragma("unroll") for (int m = 0; m < 4; ++m) _Pragma("unroll") for (int n = 0; n < 2; ++n) { \
        if constexpr (ES == 2) { _Pragma("unroll") for (int k = 0; k < 2; ++k) acc[ai][bj][m][n] = __builtin_amdgcn_mfma_f32_16x16x32_bf16(Bt[n][k], At[m][k], acc[ai][bj][m][n], 0, 0, 0); } \
        else { asm("v_mfma_scale_f32_16x16x128_f8f6f4 %0, %1, %2, %0, %3, %3 op_sel_hi:[0,0,0]" : "+v"(acc[ai][bj][m][n]) : "v"(Bt##8[n]), "v"(At##8[m]), "v"(one_scale)); PG8_MMA_PROBE(ai, bj, m, n, At, Bt) } } \
        __builtin_amdgcn_s_setprio(0); } while (0)
#ifdef MMA_REP
#define PG8_MMA_PROBE(ai, bj, m, n, At, Bt) if constexpr (MMA_REP == 0 || MMA_REP == Epi::NSTORES) asm("v_mfma_scale_f32_16x16x128_f8f6f4 %0, %1, %2, %0, %3, %3 op_sel_hi:[0,0,0]" : "+v"(acc[ai][bj][m][n]) : "v"(Bt##8[n]), "v"(At##8[m]), "v"(zero_scale));
#else
#define PG8_MMA_PROBE(ai, bj, m, n, At, Bt)
#endif
#define PG8_WAIT_V(n) asm volatile("s_waitcnt vmcnt(" #n ")" ::: "memory")
#define PG8_WAIT_L(n) asm volatile("s_waitcnt lgkmcnt(" #n ")" ::: "memory")
#define PG8_BAR __builtin_amdgcn_s_barrier()
#define PG8_SCHED __builtin_amdgcn_sched_barrier(0)
#define PG8_AVOFF(dst, u) do { const int tid_ = wid * 64 + fresh_lane(); _Pragma("unroll") for (int h_ = 0; h_ < 2; ++h_) _Pragma("unroll") for (int i_ = 0; i_ < 2; ++i_) { int R_, C_; stage_rc(tid_ * 16 + i_ * 8192, R_, C_); \
        const unsigned row_ = GATHER ? S.a_row((u), h_ * HALF + R_) : (unsigned)(h_ * HALF + R_); dst[h_][i_] = row_ * (unsigned)(lda * ES) + (unsigned)C_ * 2u; } } while (0)
#define PG8_NVOFF(dst) do { const int l_ = fresh_lane(); const int tid_ = wid * 64 + l_; _Pragma("unroll") for (int h_ = 0; h_ < 2; ++h_) _Pragma("unroll") for (int i_ = 0; i_ < 2; ++i_) { int R_, C_; stage_rc(tid_ * 16 + i_ * 8192, R_, C_); \
        const unsigned ent_ = *(const PG8_LAS unsigned*)(lds + PARK_OFF + wid * 1024 + (h_ * 2 + i_) * 256 + l_ * 4); const unsigned row_ = S.row_of(nxt, h_ * HALF + R_, ent_); dst[h_][i_] = row_ * (unsigned)(lda * ES) + (unsigned)C_ * 2u; } } while (0)
    const unsigned parkb = (unsigned)__builtin_amdgcn_readfirstlane((int)((unsigned)(uintptr_t)lds + (unsigned)PARK_OFF + (unsigned)wid * 1024u));
    Unit cur, nxt; int ui = 0;
    if (!S.next(0, cur)) return;
    f32x4 acc[2][2][4][2];
#pragma unroll
    for (int a = 0; a < 2; ++a)
#pragma unroll
        for (int b = 0; b < 2; ++b)
#pragma unroll
            for (int m = 0; m < 4; ++m)
#pragma unroll
                for (int n = 0; n < 2; ++n) acc[a][b][m][n] = (f32x4){0.f, 0.f, 0.f, 0.f};
    bf16x8 At[4][2], B0[2][2], B1[2][2]; i32x8 At8[4], B08[2], B18[2];
    unsigned vA[2][2];
    const unsigned zero_scale = 0u; (void)zero_scale;
    const unsigned one_scale = 0x7F7F7F7Fu;
    PG8_AVOFF(vA, cur);
    const char* cA = cur.a; const char* cB = cur.b;
    PG8_STAGE(PG8_SB(0, 0), cB, voffB[0], voffB[1]); PG8_STAGE(PG8_SB(0, 1), cB + hstepB, voffB[0], voffB[1]); PG8_STAGE(PG8_SA(0, 0), cA, vA[0][0], vA[0][1]); PG8_STAGE(PG8_SA(0, 1), cA, vA[1][0], vA[1][1]);
    if (wr == 1) PG8_BAR;
    PG8_WAIT_V(2); PG8_BAR;
    PG8_STAGE(PG8_SB(1, 0), cB + kstep, voffB[0], voffB[1]); PG8_STAGE(PG8_SA(1, 0), cA + kstep, vA[0][0], vA[0][1]); PG8_STAGE(PG8_SB(1, 1), cB + hstepB + kstep, voffB[0], voffB[1]);
    PG8_WAIT_V(6); PG8_BAR;
    for (;;) {
        const bool has_next = S.next(ui + 1, nxt);
        typename Epi::Pre pre; E.prefetch(pre, cur, wr, wc, fresh_lane());
        const char* nA = has_next ? nxt.a : cA; const char* nB = has_next ? nxt.b : cB;
        if (GATHER && has_next) {
            const int tid_ = wid * 64 + fresh_lane();
#pragma unroll
            for (int h_ = 0; h_ < 2; ++h_)
#pragma unroll
                for (int i_ = 0; i_ < 2; ++i_) { int R_, C_; stage_rc(tid_ * 16 + i_ * 8192, R_, C_);
                    glds_sv4(S.list_base(nxt), (unsigned)(h_ * HALF + R_) * 4u, parkb + (unsigned)(h_ * 2 + i_) * 256u); }
        }
        PG8_TS(30 + 4 * ui);
#pragma unroll 1
        for (int t = 0; t < nt; t += 2) {
            const bool last = (t == nt - 2);
            const char* a1 = cA + (size_t)(t + 1) * kstep;
            const char* a2 = last ? nA : cA + (size_t)(t + 2) * kstep; const char* b2 = last ? nB : cB + (size_t)(t + 2) * kstep;
            const char* a3 = a2 + kstep; const char* b3 = b2 + kstep;
            unsigned s00, s01, s10, s11;
            if (GATHER) { if (last && has_next) { unsigned t_[2][2]; PG8_NVOFF(t_); s00 = t_[0][0]; s01 = t_[0][1]; s10 = t_[1][0]; s11 = t_[1][1]; } else { s00 = vA[0][0]; s01 = vA[0][1]; s10 = vA[1][0]; s11 = vA[1][1]; } }
            else { s00 = vA[0][0]; s01 = vA[0][1]; s10 = vA[1][0]; s11 = vA[1][1]; }
            const bool relax = Epi::NSTORES > 0 && t == 0 && ui > 0;
            PG8_LDB(B0, 0, 0); PG8_LDB(B1, 0, 1); PG8_SCHED; PG8_LDA(At, 0, 0); PG8_STAGE(PG8_SA(1, 1), a1, vA[1][0], vA[1][1]);
            if (relax) { wait_vm<8 + Epi::NSTORES>(); } else { PG8_WAIT_V(8); } PG8_WAIT_L(0); PG8_BAR; PG8_MMA(0, 0, At, B0); PG8_MMA(0, 1, At, B1); PG8_BAR; PG8_SCHED;
            PG8_LDA(At, 0, 1); PG8_STAGE(PG8_SB(0, 0), b2, voffB[0], voffB[1]); PG8_STAGE(PG8_SB(0, 1), b2 + hstepB, voffB[0], voffB[1]); PG8_STAGE(PG8_SA(0, 0), a2, s00, s01);
            if (relax) { wait_vm<8 + Epi::NSTORES>(); } else { PG8_WAIT_V(8); } PG8_WAIT_L(0); PG8_BAR; PG8_MMA(1, 0, At, B0); PG8_MMA(1, 1, At, B1); PG8_BAR; PG8_SCHED;
            PG8_LDB(B0, 1, 0); PG8_LDB(B1, 1, 1); PG8_SCHED; PG8_LDA(At, 1, 0); PG8_STAGE(PG8_SA(0, 1), a2, s10, s11);
            PG8_WAIT_V(8); PG8_WAIT_L(0); PG8_BAR; PG8_MMA(0, 0, At, B0); PG8_MMA(0, 1, At, B1); PG8_BAR; PG8_SCHED;
            PG8_LDA(At, 1, 1); PG8_STAGE(PG8_SB(1, 0), b3, voffB[0], voffB[1]); PG8_STAGE(PG8_SB(1, 1), b3 + hstepB, voffB[0], voffB[1]); PG8_STAGE(PG8_SA(1, 0), a3, s00, s01);
            PG8_WAIT_V(8); PG8_WAIT_L(0); PG8_BAR; PG8_MMA(1, 0, At, B0); PG8_MMA(1, 1, At, B1); PG8_BAR; PG8_SCHED;
        }
        PG8_TS(31 + 4 * ui);
        if constexpr (ALIGN_EPI) { if (wr == 0) PG8_BAR; }
        if constexpr (ES == 1) asm volatile("s_nop 15\n\ts_nop 7" ::: "memory");
        const int le_ = fresh_lane(); const bool keep = E(acc, cur, wr, wc, le_ & 15, le_ >> 4, pre);
#ifdef EPI_REP
        if (!Epi::MAY_KEEP && (EPI_REP == 0 || EPI_REP == Epi::NSTORES)) { const int le2_ = fresh_lane(); (void)E(acc, cur, wr, wc, le2_ & 15, le2_ >> 4, pre); }
#endif
        PG8_TS(32 + 4 * ui);
        if (!has_next) break;
        if (!(Epi::MAY_KEEP && keep)) {
#pragma unroll
        for (int a = 0; a < 2; ++a)
#pragma unroll
            for (int b = 0; b < 2; ++b)
#pragma unroll
                for (int m = 0; m < 4; ++m)
#pragma unroll
                    for (int n = 0; n < 2; ++n) acc[a][b][m][n] = (f32x4){0.f, 0.f, 0.f, 0.f};
        }
        cur = nxt; cA = nA; cB = nB; ++ui;
        if (GATHER) { PG8_NVOFF(vA); }
        if constexpr (ALIGN_EPI) { if (wr == 1) PG8_BAR; }
    }
    PG8_WAIT_V(0);
    if constexpr (!ALIGN_EPI) { if (wr == 0) PG8_BAR; }
    PG8_BAR;
#undef PG8_SA
#undef PG8_SB
#undef PG8_STAGE
#undef PG8_LDA
#undef PG8_LDB
#undef PG8_MMA
#undef PG8_LD8
#undef PG8_WAIT_V
#undef PG8_WAIT_L
#undef PG8_BAR
#undef PG8_SCHED
#undef PG8_AVOFF
#undef PG8_NVOFF
}
}
namespace pg8 {
constexpr size_t TSTEP = (size_t)256 * 1024 * 2;

struct OrdStatic {
    int nM, nN, nwg, G, c; const char *A, *B; size_t ts;
    __device__ __forceinline__ void init(int M, int N, int G_, int c_, const void* A_, const void* B_, size_t ts_ = TSTEP) { nM = M / BM; nN = N / BM; nwg = nM * nN; G = G_; c = c_; A = (const char*)A_; B = (const char*)B_; ts = ts_; }
    __device__ __forceinline__ bool next(int i, Unit& u) const {
        const long L = (long)i * G + c; if (L >= nwg) return false;
        tile_map(xcd_remap((int)L, nwg), nM, nN, u.pm, u.pn); u.a = A + (size_t)u.pm * ts; u.b = B + (size_t)u.pn * ts; u.x0 = 0; u.x1 = 0; return true;
    }
    __device__ __forceinline__ unsigned a_row(const Unit&, int r) const { return (unsigned)r; }
    __device__ __forceinline__ const char* list_base(const Unit&) const { return nullptr; }
    __device__ __forceinline__ unsigned row_of(const Unit&, int r, unsigned) const { return (unsigned)r; }
};
struct OrdInProj {
    int G, c; const char *A, *B;
    static constexpr int nM = 64, nN = 18, nwg = nM * nN;
    __device__ __forceinline__ bool next(int i, Unit& u) const {
        long L = (long)i * G + c;
        if (L < nwg) { tile_map(xcd_remap((int)L, nwg), nM, nN, u.pm, u.pn); u.a = A + (size_t)u.pm * TSTEP; u.b = B + (size_t)u.pn * TSTEP; u.x0 = 0; u.x1 = 0; return true; }
        L -= nwg; if (L >= 4) return false;
        u.pm = (int)(L >> 1); u.pn = 4 + (int)(L & 1); u.a = A + (size_t)(64 + u.pm) * TSTEP; u.b = B + (size_t)u.pn * TSTEP; u.x0 = 1; u.x1 = 0; return true;
    }
    __device__ __forceinline__ unsigned a_row(const Unit&, int r) const { return (unsigned)r; }
    __device__ __forceinline__ const char* list_base(const Unit&) const { return nullptr; }
    __device__ __forceinline__ unsigned row_of(const Unit&, int r, unsigned) const { return (unsigned)r; }
};
struct OrdInProj8 {
    int G, c; const char *A, *B;
    static constexpr int nM = 64, nN = 14, nwg = nM * nN; static constexpr size_t TS8 = (size_t)256 * 1024;
    __device__ __forceinline__ bool next(int i, Unit& u) const {
        if (c >= G) return false;
        long L = (long)i * G + c;
        if (L < nwg) { int j; tile_map(xcd_remap((int)L, nwg), nM, nN, u.pm, j); u.pn = j < 6 ? j : j + 4; u.a = A + (size_t)u.pm * TS8; u.b = B + (size_t)u.pn * TS8; u.x0 = 0; u.x1 = 0; return true; }
        L -= nwg; if (L >= 4) return false;
        u.pm = (int)(L >> 1); u.pn = 4 + (int)(L & 1); u.a = A + (size_t)(64 + u.pm) * TS8; u.b = B + (size_t)u.pn * TS8; u.x0 = 1; u.x1 = 0; return true;
    }
    __device__ __forceinline__ unsigned a_row(const Unit&, int r) const { return (unsigned)r; }
    __device__ __forceinline__ const char* list_base(const Unit&) const { return nullptr; }
    __device__ __forceinline__ unsigned row_of(const Unit&, int r, unsigned) const { return (unsigned)r; }
};
struct OrdInProjU {
    int G, c; const char *A, *B;
    static constexpr int nM = 64, nN = 4, nwg = nM * nN;
    __device__ __forceinline__ bool next(int i, Unit& u) const {
        const long L = (long)i * G + c; if (L >= nwg) return false;
        int j; tile_map(xcd_remap((int)L, nwg), nM, nN, u.pm, j); u.pn = 6 + j; u.a = A + (size_t)u.pm * TSTEP; u.b = B + (size_t)u.pn * TSTEP; u.x0 = 0; u.x1 = 0; return true;
    }
    __device__ __forceinline__ unsigned a_row(const Unit&, int r) const { return (unsigned)r; }
    __device__ __forceinline__ const char* list_base(const Unit&) const { return nullptr; }
    __device__ __forceinline__ unsigned row_of(const Unit&, int r, unsigned) const { return (unsigned)r; }
};
struct OrdMerge {
    int G, c; const char *A0, *A1, *B0, *B1;
    static constexpr int nM = 64, nN = 4, nwg = nM * nN;
    __device__ __forceinline__ bool next(int i, Unit& u) const {
        const long L = (long)(i >> 1) * G + c; if (L >= nwg) return false;
        tile_map(xcd_remap((int)L, nwg), nM, nN, u.pm, u.pn); const int p = i & 1;
        u.a = (p ? A1 : A0) + (size_t)u.pm * ((size_t)256 * 1024); u.b = (p ? B1 : B0) + (size_t)u.pn * ((size_t)256 * 1024); u.x0 = p;     u.x1 = 0; return true;
    }
    __device__ __forceinline__ unsigned a_row(const Unit&, int r) const { return (unsigned)r; }
    __device__ __forceinline__ const char* list_base(const Unit&) const { return nullptr; }
    __device__ __forceinline__ unsigned row_of(const Unit&, int r, unsigned) const { return (unsigned)r; }
};
struct OrdMoe {
    int G, c, nN; const volatile PG8_LAS int* pt; const volatile PG8_LAS int* cn; const char *A, *B; size_t bstride, tstep; const int* list; int gather;
    __device__ __forceinline__ bool next(int i, Unit& u) const {
        if (c >= G) return false;
        const int total = __builtin_amdgcn_readfirstlane(pt[32]) * nN; const long L = (long)i * G + c; if (L >= total) return false;
        const int w = xcd_remap((int)L, total);
        const int ln_ = (int)(threadIdx.x & 63); const int ptl_ = pt[ln_ < 32 ? ln_ : 32];
        const unsigned long long bm_ = __ballot(ln_ < 32 && w >= ptl_ * nN);
        const int e = __builtin_amdgcn_readfirstlane(__builtin_popcountll(bm_) - 1);
        const int p0 = __builtin_amdgcn_readfirstlane(pt[e]), te = __builtin_amdgcn_readfirstlane(pt[e + 1]) - p0, loc = w - p0 * nN;
#ifndef MOE_PN_FAST
        u.pn = loc / te; const int mt = loc - u.pn * te; u.pm = p0 + mt; u.x0 = e; u.x1 = mt;
#else
        const int mt = loc / nN; u.pn = loc - mt * nN; u.pm = p0 + mt; u.x0 = e; u.x1 = mt; (void)te;
#endif
        u.a = gather ? A : A + (size_t)u.pm * tstep; u.b = B + (size_t)e * bstride + (size_t)u.pn * tstep; return true;
    }
    __device__ __forceinline__ unsigned a_row(const Unit& u, int r) const { const int rr = u.x1 * 256 + r; return rr < cn[u.x0] ? (unsigned)(list[u.x0 * 16384 + rr] >> 2) : 0u; }
    __device__ __forceinline__ const char* list_base(const Unit& u) const { return (const char*)(list + u.x0 * 16384 + u.x1 * 256); }
    __device__ __forceinline__ unsigned row_of(const Unit& u, int r, unsigned ent) const { const int rr = u.x1 * 256 + r; return rr < cn[u.x0] ? (ent >> 2) : 0u; }
};

struct EpiInProj {
    static constexpr int NSTORES = 16;
    struct Pre { f32x4 bv[2][2]; };
    __device__ __forceinline__ void prefetch(Pre& p, const Unit& u, int wr, int wc, int lane) const { const int ct = wc * 32 + 8 * (lane >> 4);
#pragma unroll
        for (int bj = 0; bj < 2; ++bj)
#pragma unroll
            for (int n = 0; n < 2; ++n) p.bv[bj][n] = *(const f32x4*)(bias + (u.pn < 10 ? u.pn * 256 + bj * HALF : 2560 + bj * 1024 + (u.pn - 10) * HALF) + ct + 4 * n); }
    static constexpr bool PERM = true, MAY_KEEP = false;
    const float* bias; bf16_t *Q, *Kx, *U; size_t kv_stride, u_stride; const float *rc, *rs; float accs;
    __device__ __forceinline__ bool operator()(f32x4 (&acc)[2][2][4][2], const Unit& u, int wr, int wc, int fr, int fq, const Pre& pre) const {
        const int pn = u.pn, ctx = u.x0, ct = wc * 32 + 8 * fq;
        if (pn < 6) {
            const float sgn = fq < 2 ? -1.0f : 1.0f; const int p0 = 8 * (fq & 1);
#pragma unroll
            for (int ai = 0; ai < 2; ++ai)
#pragma unroll
                for (int m = 0; m < 4; ++m) {
                    const int rt = u.pm * BM + ai * HALF + wr * 64 + m * 16 + fr;
                    int b, l; if (ctx) { b = rt >> 8; l = rt & 255; } else { b = rt >> 13; l = rt & 8191; }
                    bf16_t* dst; float sc = 1.f; bool rope;
                    if (pn < 4) { dst = Q + (size_t)rt * 1024 + pn * 256; sc = ATT_C2; rope = true; }
                    else { const size_t erow = (size_t)b * 8448 + (ctx ? l : 256 + l); dst = Kx + (size_t)(pn - 4) * kv_stride + erow * 256; rope = (pn == 4) && !ctx; }
                    f32x4 cs[2], sn[2];
#pragma unroll
                    for (int n = 0; n < 2; ++n) { cs[n] = (f32x4){1.f, 1.f, 1.f, 1.f}; sn[n] = (f32x4){0.f, 0.f, 0.f, 0.f}; }
                    if (rope) { const int ti = (wc & 1) ? 128 + (l & 63) : (l >> 6);
#pragma unroll
                        for (int n = 0; n < 2; ++n) { cs[n] = *(const f32x4*)(rc + ti * 16 + p0 + 4 * n); sn[n] = *(const f32x4*)(rs + ti * 16 + p0 + 4 * n) * sgn; } }
#pragma unroll
                    for (int bj = 0; bj < 2; ++bj) {
                        f32x4 o[2];
#pragma unroll
                        for (int n = 0; n < 2; ++n) {
                            const f32x4 v = acc[ai][bj][m][n] * accs + pre.bv[bj][n]; f32x4 ot = v;
                            if (rope) {
#pragma unroll
                                for (int i = 0; i < 4; ++i) { const unsigned x = __float_as_uint(v[i]); auto r = __builtin_amdgcn_permlane32_swap(x, x, false, false); ot[i] = __uint_as_float(fq < 2 ? r[1] : r[0]); }
                            }
                            o[n] = rope ? (v * cs[n] + ot * sn[n]) * sc : v * sc;
                        }
                        u32x4 w; w.x = pk2(o[0][0], o[0][1]); w.y = pk2(o[0][2], o[0][3]); w.z = pk2(o[1][0], o[1][1]); w.w = pk2(o[1][2], o[1][3]);
                        *(u32x4*)(dst + bj * HALF + ct) = w;
                    }
                }
        } else if (pn >= 10) {
            const int gc = (pn - 10) * HALF + ct;
#pragma unroll
            for (int ai = 0; ai < 2; ++ai)
#pragma unroll
                for (int m = 0; m < 4; ++m) {
                    const size_t ro = (size_t)(u.pm * BM + ai * HALF + wr * 64 + m * 16 + fr) * 1024 + gc;
                    f32x4 r[2], p[2];
#pragma unroll
                    for (int n = 0; n < 2; ++n) { const f32x4 ga = acc[ai][0][m][n] * accs + pre.bv[0][n], gp = acc[ai][1][m][n] * accs + pre.bv[1][n];
#pragma unroll
                        for (int i = 0; i < 4; ++i) { const float sp_ = fsigmoid(gp[i]); p[n][i] = sp_; r[n][i] = fsigmoid(ga[i]) * __builtin_amdgcn_rcpf(fmaxf(sp_, 1e-30f)); } }
                    u32x4 w; w.x = pk2(r[0][0], r[0][1]); w.y = pk2(r[0][2], r[0][3]); w.z = pk2(r[1][0], r[1][1]); w.w = pk2(r[1][2], r[1][3]);
                    *(u32x4*)(U + u_stride + ro) = w;
                    w.x = pk2(p[0][0], p[0][1]); w.y = pk2(p[0][2], p[0][3]); w.z = pk2(p[1][0], p[1][1]); w.w = pk2(p[1][2], p[1][3]);
                    *(u32x4*)(U + 2 * u_stride + ro) = w;
                }
        } else {
            const int sel = 0, cb = (pn - 6) * 256; bf16_t* base = U;
#pragma unroll
            for (int ai = 0; ai < 2; ++ai)
#pragma unroll
                for (int m = 0; m < 4; ++m) {
                    bf16_t* dst = base + (size_t)(u.pm * BM + ai * HALF + wr * 64 + m * 16 + fr) * 1024 + cb;
#pragma unroll
                    for (int bj = 0; bj < 2; ++bj) {
                        f32x4 v0 = acc[ai][bj][m][0] * accs + pre.bv[bj][0], v1 = acc[ai][bj][m][1] * accs + pre.bv[bj][1];
                        if (sel) { v0[0] = fsigmoid(v0[0]); v0[1] = fsigmoid(v0[1]); v0[2] = fsigmoid(v0[2]); v0[3] = fsigmoid(v0[3]); v1[0] = fsigmoid(v1[0]); v1[1] = fsigmoid(v1[1]); v1[2] = fsigmoid(v1[2]); v1[3] = fsigmoid(v1[3]); }
                        u32x4 w; w.x = pk2(v0[0], v0[1]); w.y = pk2(v0[2], v0[3]); w.z = pk2(v1[0], v1[1]); w.w = pk2(v1[2], v1[3]);
                        *(u32x4*)(dst + bj * HALF + ct) = w;
                    }
                }
        }
        return false;
    }
};
struct EpiMerge {
    static constexpr int NSTORES = 0;
    struct Pre {}; __device__ __forceinline__ void prefetch(Pre&, const Unit&, int, int, int) const {}
    static constexpr bool PERM = true, MAY_KEEP = true;
    const bf16_t *SA, *SP; unsigned char* O;
    __device__ __forceinline__ bool operator()(f32x4 (&acc)[2][2][4][2], const Unit& u, int wr, int wc, int fr, int fq, const Pre& pre) const {
        const int col0 = u.pn * BM + wc * 32 + 8 * fq;
        const bf16_t* G = u.x0 == 0 ? SA : SP;
        u32x4 g[2][4][2];
#pragma unroll
        for (int ai = 0; ai < 2; ++ai)
#pragma unroll
            for (int m = 0; m < 4; ++m)
#pragma unroll
                for (int bj = 0; bj < 2; ++bj) g[ai][m][bj] = __builtin_nontemporal_load((const u32x4*)(G + (size_t)(u.pm * BM + ai * HALF + wr * 64 + m * 16 + fr) * 1024 + col0 + bj * HALF));
#pragma unroll
        for (int ai = 0; ai < 2; ++ai)
#pragma unroll
            for (int m = 0; m < 4; ++m) {
                const size_t off = (size_t)(u.pm * BM + ai * HALF + wr * 64 + m * 16 + fr) * 1024 + col0;
#pragma unroll
                for (int bj = 0; bj < 2; ++bj) {
                    const u32x4 gq = g[ai][m][bj];
                    float sg[8] = {bflo(gq.x), bfhi(gq.x), bflo(gq.y), bfhi(gq.y), bflo(gq.z), bfhi(gq.z), bflo(gq.w), bfhi(gq.w)};
                    if (u.x0 == 0) {
#pragma unroll
                        for (int n = 0; n < 2; ++n)
#pragma unroll
                            for (int i = 0; i < 4; ++i) acc[ai][bj][m][n][i] *= sg[4 * n + i];
                    } else {
                        f32x4 v0 = acc[ai][bj][m][0], v1 = acc[ai][bj][m][1];
#pragma unroll
                        for (int i = 0; i < 4; ++i) { v0[i] *= (MRG_SCALE / (PB_ASCALE * MOE_WSCALE)) * fmaxf(sg[i], 1e-30f); v1[i] *= (MRG_SCALE / (PB_ASCALE * MOE_WSCALE)) * fmaxf(sg[4 + i], 1e-30f); }
                        u32x2 w; w.x = pk4_fp8(v0[0], v0[1], v0[2], v0[3]); w.y = pk4_fp8(v1[0], v1[1], v1[2], v1[3]);
                        __builtin_amdgcn_raw_buffer_store_b64(w, __builtin_amdgcn_make_buffer_rsrc((void*)O, 0, 0x7fffffff, 0x00020000), (int)(off + bj * HALF), 0, 16  );
                    }
                }
            }
        return u.x0 == 0;
    }
};
struct EpiOut {
    static constexpr int NSTORES = 16;
    struct Pre {}; __device__ __forceinline__ void prefetch(Pre&, const Unit&, int, int, int) const {}
    static constexpr bool PERM = true, MAY_KEEP = false;
    const float* modx; bf16_t* delta;
    __device__ __forceinline__ bool operator()(f32x4 (&acc)[2][2][4][2], const Unit& u, int wr, int wc, int fr, int fq, const Pre& pre) const {
        const int col0 = u.pn * BM + wc * 32 + 8 * fq; const int b = (u.pm * BM) >> 13;
        f32x4 g[2][2];
#pragma unroll
        for (int bj = 0; bj < 2; ++bj)
#pragma unroll
            for (int n = 0; n < 2; ++n) g[bj][n] = *(const f32x4*)(modx + b * 6144 + 2048 + col0 + bj * HALF + 4 * n) * (1.0f / (MRG_SCALE * MOE_WSCALE));
#pragma unroll
        for (int ai = 0; ai < 2; ++ai)
#pragma unroll
            for (int m = 0; m < 4; ++m) {
                const size_t off = (size_t)(u.pm * BM + ai * HALF + wr * 64 + m * 16 + fr) * 1024 + col0;
#pragma unroll
                for (int bj = 0; bj < 2; ++bj) { const f32x4 v0 = g[bj][0] * acc[ai][bj][m][0], v1 = g[bj][1] * acc[ai][bj][m][1];
                    u32x4 w; w.x = pk2(v0[0], v0[1]); w.y = pk2(v0[2], v0[3]); w.z = pk2(v1[0], v1[1]); w.w = pk2(v1[2], v1[3]); __builtin_amdgcn_raw_buffer_store_b128(w, __builtin_amdgcn_make_buffer_rsrc((void*)delta, 0, 0x7fffffff, 0x00020000), (int)((off + bj * HALF) * 2), 0, 16  ); }
            }
        return false;
    }
};
struct EpiSwiglu {
    static constexpr int NSTORES = 8;
    struct Pre { f32x4 bg[2], bl[2]; };
    __device__ __forceinline__ void prefetch(Pre& p, const Unit& u, int wr, int wc, int lane) const { const int ca = u.pn * HALF + wc * 32 + 8 * (lane >> 4); const float* be = bgu + (size_t)u.x0 * 2048;
#pragma unroll
        for (int n = 0; n < 2; ++n) { p.bg[n] = *(const f32x4*)(be + ca + 4 * n); p.bl[n] = *(const f32x4*)(be + 1024 + ca + 4 * n); } }
    static constexpr bool PERM = true, MAY_KEEP = false;
    const float* bgu; unsigned char* ACT;
    __device__ __forceinline__ bool operator()(f32x4 (&acc)[2][2][4][2], const Unit& u, int wr, int wc, int fr, int fq, const Pre& pre) const {
        const int ca = u.pn * HALF + wc * 32 + 8 * fq; constexpr float iw = 1.0f / MOE_WSCALE;
        f32x4 bg[2], bl[2];
#pragma unroll
        for (int n = 0; n < 2; ++n) { bg[n] = pre.bg[n]; bl[n] = pre.bl[n]; }
#pragma unroll
        for (int ai = 0; ai < 2; ++ai)
#pragma unroll
            for (int m = 0; m < 4; ++m) {
                unsigned char* dst = ACT + (size_t)(u.pm * BM + ai * HALF + wr * 64 + m * 16 + fr) * 1024 + ca;
                float o[8];
#pragma unroll
                for (int n = 0; n < 2; ++n)
#pragma unroll
                    for (int i = 0; i < 4; ++i) {
                        const float gt = fminf(acc[ai][0][m][n][i] * iw + bg[n][i], 7.0f);
                        const float ln = fminf(fmaxf(acc[ai][1][m][n][i] * iw + bl[n][i], -7.0f), 7.0f);
                        o[4 * n + i] = (MOE_ASCALE * gt) * fsigmoid(1.702f * gt) * (ln + 1.0f);
                    }
                u32x2 w; w.x = pk4_fp8(o[0], o[1], o[2], o[3]); w.y = pk4_fp8(o[4], o[5], o[6], o[7]);
                *(u32x2*)dst = w;
            }
        return false;
    }
};
struct EpiDown {
    static constexpr int NSTORES = 0;
    struct Pre { int ent[2][4]; f32x4 bv[2][2]; };
    static constexpr bool PERM = true, MAY_KEEP = false;
    const float* bd; unsigned char* Y2; const int* list; const volatile PG8_LAS int* cn;
    __device__ __forceinline__ void prefetch(Pre& p, const Unit& u, int wr, int wc, int lane) const {
        const int cnt = cn[u.x0], fr = lane & 15;
#pragma unroll
        for (int ai = 0; ai < 2; ++ai)
#pragma unroll
            for (int m = 0; m < 4; ++m) { const int rr = u.x1 * 256 + ai * HALF + wr * 64 + m * 16 + fr; p.ent[ai][m] = rr < cnt ? list[u.x0 * 16384 + rr] : -1; }
        const int col0 = u.pn * BM + wc * 32 + 8 * (lane >> 4); const float* be = bd + (size_t)u.x0 * 1024;
#pragma unroll
        for (int bj = 0; bj < 2; ++bj)
#pragma unroll
            for (int n = 0; n < 2; ++n) p.bv[bj][n] = *(const f32x4*)(be + col0 + bj * HALF + 4 * n);
    }
    __device__ __forceinline__ bool operator()(f32x4 (&acc)[2][2][4][2], const Unit& u, int wr, int wc, int fr, int fq, const Pre& pre) const {
        const int col0 = u.pn * BM + wc * 32 + 8 * fq; constexpr float iws = Y2_SCALE / (MOE_WSCALE * MOE_ASCALE); const int odd = fq & 1;
        f32x4 bv[2][2];
#pragma unroll
        for (int bj = 0; bj < 2; ++bj)
#pragma unroll
            for (int n = 0; n < 2; ++n) bv[bj][n] = pre.bv[bj][n] * Y2_SCALE;
#pragma unroll
        for (int ai = 0; ai < 2; ++ai)
#pragma unroll
            for (int mp = 0; mp < 2; ++mp) {
                const int ent = odd ? pre.ent[ai][2 * mp + 1] : pre.ent[ai][2 * mp];
#pragma unroll
                for (int bj = 0; bj < 2; ++bj) {
                    u32x2 w[2];
#pragma unroll
                    for (int mm = 0; mm < 2; ++mm) { const int m = 2 * mp + mm; const f32x4 v0 = acc[ai][bj][m][0] * iws + bv[bj][0], v1 = acc[ai][bj][m][1] * iws + bv[bj][1];
                        w[mm].x = pk4_fp8(v0[0], v0[1], v0[2], v0[3]); w[mm].y = pk4_fp8(v1[0], v1[1], v1[2], v1[3]); }
                    const u32x2 send = odd ? w[0] : w[1], keep = odd ? w[1] : w[0];
                    u32x2 recv; recv.x = (unsigned)__shfl_xor((int)send.x, 16); recv.y = (unsigned)__shfl_xor((int)send.y, 16);
                    const u32x4 o16 = odd ? (u32x4){recv.x, recv.y, keep.x, keep.y} : (u32x4){keep.x, keep.y, recv.x, recv.y};
                    if (ent >= 0) *(u32x4*)(Y2 + (size_t)ent * 1024 + col0 - 8 * odd + bj * HALF) = o16;
                }
            }
        return false;
    }
};
struct OrdFold {
    int c0, c; const char *A, *B;
    __device__ __forceinline__ bool next(int i, Unit& u) const {
        const int j = c - c0; if (i != 0 || j < 0 || j >= 16) return false;
        u.pm = j & 3; u.pn = j >> 2; u.a = A + (size_t)(u.pn * 1024 + u.pm * 256) * 256 * 2; u.b = B + (size_t)u.pn * 256 * 256 * 2; u.x0 = 0; u.x1 = 0; return true;
    }
    __device__ __forceinline__ unsigned a_row(const Unit&, int r) const { return (unsigned)r; }
    __device__ __forceinline__ const char* list_base(const Unit&) const { return nullptr; }
    __device__ __forceinline__ unsigned row_of(const Unit&, int r, unsigned) const { return (unsigned)r; }
};
struct EpiFold {
    static constexpr int NSTORES = 16; static constexpr bool PERM = true, MAY_KEEP = false;
    struct Pre {}; __device__ __forceinline__ void prefetch(Pre&, const Unit&, int, int, int) const {}
    unsigned char* O;
    __device__ __forceinline__ bool operator()(f32x4 (&acc)[2][2][4][2], const Unit& u, int wr, int wc, int fr, int fq, const Pre&) const {
        const int col0 = u.pn * BM + wc * 32 + 8 * fq;
#pragma unroll
        for (int ai = 0; ai < 2; ++ai)
#pragma unroll
            for (int m = 0; m < 4; ++m) {
                unsigned char* dst = O + (size_t)(u.pm * BM + ai * HALF + wr * 64 + m * 16 + fr) * 1024 + col0;
#pragma unroll
                for (int bj = 0; bj < 2; ++bj) { const f32x4 v0 = acc[ai][bj][m][0] * MOE_WSCALE, v1 = acc[ai][bj][m][1] * MOE_WSCALE;
                    u32x2 w; w.x = pk4_fp8(v0[0], v0[1], v0[2], v0[3]); w.y = pk4_fp8(v1[0], v1[1], v1[2], v1[3]); *(u32x2*)(dst + bj * HALF) = w; }
            }
        return false;
    }
};
}
namespace attn_body {
using bf16=__hip_bfloat16;
using bf16x8=__attribute__((ext_vector_type(8)))short;
using s16x4=__attribute__((ext_vector_type(4)))short;
using f32x16=__attribute__((ext_vector_type(16)))float;
using u32x4=__attribute__((ext_vector_type(4)))unsigned;
constexpr int BATCH=2,NHEAD=16,SEQ=8192,D=64,DM=NHEAD*D;
constexpr int NW=8,QBLK=32,QB=QBLK*NW,KVBLK=64,NQB=SEQ/QB;
constexpr int UROWS=128;
constexpr int ATTN_PITCH=DM, ATTN_UNIT_ROWS=QB;
constexpr int KP=256, KVROWS=8448, CTXT=4;
__device__ __forceinline__ int crow(int r,int hi){return (r&3)+8*(r>>2)+4*hi;}
#define SBAR() __builtin_amdgcn_sched_barrier(0)
__device__ __forceinline__ void cmask(f32x16&p0,f32x16&p1,int db,int hi){
  const float NEG=-INFINITY; const int kb=db+4*hi;
  #pragma unroll
  for(int r=0;r<16;++r){const int kv=kb+(r&3)+8*(r>>2); if((unsigned)kv>256u)p0[r]=NEG; if((unsigned)(kv+32)>256u)p1[r]=NEG;}
}

constexpr int NSLOT=3, SLOTB=8192;
constexpr int LDS_K=0, LDS_V=NSLOT*SLOTB, LDS_WS=2*NSLOT*SLOTB, LDS_OST=LDS_WS+NW*64*4, LDS_BYTES=LDS_OST+NW*4096;
constexpr float C2=0.125f*1.4426950408889634f;
__device__ __forceinline__ void glds16(const void*gsrc,unsigned lds_dst){unsigned keep;
  asm volatile("s_mov_b32 %0, m0\n\ts_mov_b32 m0, %2\n\ts_nop 0\n\tglobal_load_lds_dwordx4 %1, off\n\ts_mov_b32 m0, %0":"=&s"(keep):"v"(gsrc),"s"(lds_dst):"memory");}
__device__ __forceinline__ float max3f(float a,float b,float c){float r;asm("v_max3_f32 %0, %1, %2, %3":"=v"(r):"v"(a),"v"(b),"v"(c));return r;}
__device__ __forceinline__ float max2f(float a,float b){float r;asm("v_max_f32_e32 %0, %1, %2":"=v"(r):"v"(a),"v"(b));return r;}
__device__ __forceinline__ float fadd_s(float a,float b){float r;asm("v_add_f32_e32 %0, %1, %2":"=v"(r):"v"(a),"v"(b));return r;}
__device__ __forceinline__ float fsub_s(float a,float b){float r;asm("v_sub_f32_e32 %0, %1, %2":"=v"(r):"v"(a),"v"(b));return r;}
typedef float f32x2_t __attribute__((ext_vector_type(2))); typedef __bf16 bf16x2_t __attribute__((ext_vector_type(2)));
__device__ __forceinline__ unsigned cvtpk_s(float lo,float hi){f32x2_t v={lo,hi};bf16x2_t b=__builtin_convertvector(v,bf16x2_t);return __builtin_bit_cast(unsigned,b);}
#define WAIT_BAR(N) asm volatile("s_waitcnt vmcnt(" #N ") lgkmcnt(0)\n\ts_barrier":::"memory")

__device__ __forceinline__ void qkt(f32x16&p0,f32x16&p1,const char*Kslot,const bf16x8*qr,const f32x16&negm,int r32,int hi){
  const char*kb=Kslot+hi*1024+r32*16;
  #pragma unroll
  for(int d0=0;d0<4;++d0){
    const bf16x8 b0=*reinterpret_cast<const bf16x8*>(kb+d0*2048);
    const bf16x8 b1=*reinterpret_cast<const bf16x8*>(kb+d0*2048+512);
    if(d0==0){p0=__builtin_amdgcn_mfma_f32_32x32x16_bf16(b0,qr[0],negm,0,0,0);p1=__builtin_amdgcn_mfma_f32_32x32x16_bf16(b1,qr[0],negm,0,0,0);}
    else{p0=__builtin_amdgcn_mfma_f32_32x32x16_bf16(b0,qr[d0],p0,0,0,0);p1=__builtin_amdgcn_mfma_f32_32x32x16_bf16(b1,qr[d0],p1,0,0,0);}}
}
typedef __attribute__((address_space(3))) const char* lds_cptr;
typedef short v4i16_t __attribute__((ext_vector_type(4)));
__device__ __forceinline__ void kload8(bf16x8*kf,lds_cptr kp){
  kf[0]=*(const __attribute__((address_space(3))) bf16x8*)(kp);      kf[1]=*(const __attribute__((address_space(3))) bf16x8*)(kp+512);
  kf[2]=*(const __attribute__((address_space(3))) bf16x8*)(kp+2048); kf[3]=*(const __attribute__((address_space(3))) bf16x8*)(kp+2560);
  kf[4]=*(const __attribute__((address_space(3))) bf16x8*)(kp+4096); kf[5]=*(const __attribute__((address_space(3))) bf16x8*)(kp+4608);
  kf[6]=*(const __attribute__((address_space(3))) bf16x8*)(kp+6144); kf[7]=*(const __attribute__((address_space(3))) bf16x8*)(kp+6656);
}
__device__ __forceinline__ void kload2(bf16x8*kf,lds_cptr kp,int j){ kf[2*j]=*(const __attribute__((address_space(3))) bf16x8*)(kp+j*2048); kf[2*j+1]=*(const __attribute__((address_space(3))) bf16x8*)(kp+j*2048+512); }
__device__ __forceinline__ s16x4 vtr(lds_cptr p){ return __builtin_bit_cast(s16x4,__builtin_amdgcn_ds_read_tr16_b64_v4i16((__attribute__((address_space(3))) v4i16_t*)p)); }
__device__ __forceinline__ float rowmax(const f32x16&p0,const f32x16&p1){
  float a=max3f(p0[0],p0[1],p1[0]),b=max3f(p0[2],p0[3],p1[1]);a=max3f(a,p1[2],p1[3]);
  #pragma unroll
  for(int r=4;r<16;r+=4){a=max3f(a,p0[r],p0[r+1]);b=max3f(b,p0[r+2],p0[r+3]);a=max3f(a,p1[r],p1[r+1]);b=max3f(b,p1[r+2],p1[r+3]);}
  const float m=max2f(a,b);
  auto rr=__builtin_amdgcn_permlane32_swap(__float_as_uint(m),__float_as_uint(m),false,false);
  return max2f(__uint_as_float(rr[0]),__uint_as_float(rr[1]));
}
__device__ __forceinline__ void pv(f32x16*o,int vb,bf16x8 pa0,bf16x8 pa1,bf16x8 pa2,bf16x8 pa3){
  #pragma unroll
  for(int d0=0;d0<2;++d0){s16x4 lo[4],hi[4];
    #pragma unroll
    for(int ks=0;ks<4;++ks){
      asm volatile("ds_read_b64_tr_b16 %0,%1 offset:%c2":"=&v"(lo[ks]):"v"(vb),"i"(d0*4096+ks*1024):"memory");
      asm volatile("ds_read_b64_tr_b16 %0,%1 offset:%c2":"=&v"(hi[ks]):"v"(vb),"i"(d0*4096+ks*1024+512):"memory");}
    asm volatile("s_waitcnt lgkmcnt(0)":::"memory");SBAR();
    #define PK(k) (bf16x8){lo[k][0],lo[k][1],lo[k][2],lo[k][3],hi[k][0],hi[k][1],hi[k][2],hi[k][3]}
    o[d0]=__builtin_amdgcn_mfma_f32_32x32x16_bf16(pa0,PK(0),o[d0],0,0,0);
    o[d0]=__builtin_amdgcn_mfma_f32_32x32x16_bf16(pa1,PK(1),o[d0],0,0,0);
    o[d0]=__builtin_amdgcn_mfma_f32_32x32x16_bf16(pa2,PK(2),o[d0],0,0,0);
    o[d0]=__builtin_amdgcn_mfma_f32_32x32x16_bf16(pa3,PK(3),o[d0],0,0,0);
    #undef PK
  }
}

#ifndef ATTN_STORE16
#define ATTN_STORE16(p,v) (*(u32x4*)(p)=(v))
#endif
template<int THRL> __device__ __forceinline__ void attn_unit(int b,int h,int qb,const bf16*Q,const bf16*__restrict__ K,const bf16*__restrict__ V,bf16*O,const float*sink,char*shm){
  const int tid=threadIdx.x,lane=tid&63,r32=lane&31,hi=lane>>5; const int wid=__builtin_amdgcn_readfirstlane(tid>>6);
  const long rowbase=(long)b*SEQ; const int q0=qb*UROWS;
  const int hw=2*h+(wid>>2), wq=(wid&3)*QBLK;
  const bf16*Qw=Q+(rowbase+q0+wq)*DM+hw*D;
  const bf16*Kh=K+(long)b*KVROWS*KP+(h>>1)*D,*Vh=V+(long)b*KVROWS*KP+(h>>1)*D;
  const int jlo=(q0>=128)?(q0-128):0, jhi=(q0+UROWS+128<=SEQ)?(q0+UROWS+128):SEQ; const int TLO=CTXT+jlo/KVBLK;
  #define TIX(t) (((t)<CTXT)?(t):(TLO+(t)-CTXT))
  const unsigned lds0=(unsigned)(uintptr_t)shm;
  float*wsf=(float*)(shm+LDS_WS)+wid*64;
  const bf16*ksrc=Kh+(long)lane*KP+wid*8;
  const bf16*vsrc=Vh+(long)(16*(wid&3)+(lane>>2))*KP+(wid>>2)*32+(lane&3)*8;
  const unsigned kdst=lds0+LDS_K+wid*1024, vdst=lds0+LDS_V+wid*1024;
  #define DMA_K(t,slot) glds16(ksrc+(long)TIX(t)*KVBLK*KP,(unsigned)__builtin_amdgcn_readfirstlane(kdst+(slot)))
  #define DMA_V(t,slot) glds16(vsrc+(long)TIX(t)*KVBLK*KP,(unsigned)__builtin_amdgcn_readfirstlane(vdst+(slot)))
  const int vb0=(int)(lds0+LDS_V)+((lane>>4)&1)*32+(lane&3)*8+(4*hi+((lane&15)>>2))*64;
  const char*Kbase=shm+LDS_K; bf16x8 kf[8];
  const lds_cptr shm3=(lds_cptr)shm; const lds_cptr kp0=shm3+LDS_K+hi*1024+r32*16; const lds_cptr vp0=shm3+LDS_V+((lane>>4)&1)*32+(lane&3)*8+(4*hi+((lane&15)>>2))*64;
  const int NT=CTXT+(jhi-jlo)/KVBLK;
  DMA_K(0,0);DMA_V(0,0);DMA_K(1,SLOTB);
  bf16x8 qr[4];
  #pragma unroll
  for(int d0=0;d0<4;++d0)qr[d0]=*reinterpret_cast<const bf16x8*>(&Qw[(long)r32*DM+d0*16+hi*8]);
  float mhat=0.f,l_reg=0.f;f32x16 o[2];o[0]=f32x16{};o[1]=f32x16{};f32x16 negm=f32x16{};asm volatile("":"+v"(negm));
  const int qpos=q0+wq+r32;
  #define CMASK(P0,P1,t) do{ if((t)>=CTXT){ cmask(P0,P1,(TIX(t)-CTXT)*KVBLK-qpos+128,hi); } }while(0)
  bool resc=false;
  #define START(P0,P1) do{ const float rm=rowmax(P0,P1); resc=false; \
    { const float dl=rm; mhat=fadd_s(mhat,dl); \
      _Pragma("unroll") for(int r=0;r<16;++r){P0[r]=fsub_s(P0[r],dl);P1[r]=fsub_s(P1[r],dl);} \
      _Pragma("unroll") for(int r=0;r<16;++r)negm[r]=-mhat; asm volatile("":"+v"(negm)); } \
    _Pragma("unroll") for(int r=0;r<16;++r)P0[r]=__builtin_amdgcn_exp2f(P0[r]); }while(0)
  #define RESC() do{ if(resc){ asm volatile("s_waitcnt lgkmcnt(0)":::"memory"); \
      _Pragma("unroll") for(int d_=0;d_<2;++d_) _Pragma("unroll") for(int r=0;r<16;++r)o[d_][r]*=wsf[crow(r,hi)]; } }while(0)
  f32x16 pA0,pA1,pB0,pB1;
  int sl_prev=0,sl_cur=0,sl_next=SLOTB;
  #define ROT() do{sl_prev=sl_cur;sl_cur=sl_next;sl_next=(sl_next==(NSLOT-1)*SLOTB)?0:sl_next+SLOTB;}while(0)
  DMA_K(2,2*SLOTB);
  WAIT_BAR(3);
  qkt(pA0,pA1,Kbase,qr,negm,r32,hi);asm volatile("s_nop 15\n\ts_nop 7":"+v"(pA0),"+v"(pA1));CMASK(pA0,pA1,0);
  START(pA0,pA1);
  _Pragma("unroll") for(int r=0;r<16;++r)pA1[r]=__builtin_amdgcn_exp2f(pA1[r]);
  WAIT_BAR(0);
  DMA_K(3,0);DMA_V(1,SLOTB);
  ROT();
  kload8(kf,kp0+sl_cur);
  WAIT_BAR(2);
  s16x4 vlo[8],vhi[8]; u32x4 pw0,pw1,pw2,pw3;
  #define PKW(P,B) cvtpk_s(P[B],P[B+1])
  #define PAF(k) __builtin_bit_cast(bf16x8,pw##k)
  #define VFR(i) (bf16x8){vlo[i][0],vlo[i][1],vlo[i][2],vlo[i][3],vhi[i][0],vhi[i][1],vhi[i][2],vhi[i][3]}
  #define PIN(x) asm volatile("":"+v"(x))
  #define MX3(a,b,c) __builtin_fmaxf(__builtin_fmaxf((a),(b)),(c))
  #define GAPA(MF,A0,A1,A2,A3,W0,W1,PW) do{ MF; sacc+=A0; sacc+=A1; sacc+=A2; sacc+=A3; PIN(sacc); W0; W1; PIN(PW); SBAR(); }while(0)
  #define EX(v) __builtin_amdgcn_exp2f(v)
  #define GAPB(MF,X,B) do{ MF; X[B]=EX(X[B]); X[B+1]=EX(X[B+1]); X[B+2]=EX(X[B+2]); X[B+3]=EX(X[B+3]); PIN(X); SBAR(); }while(0)
  #define VRD(i) do{ vlo[i]=vtr(vp_+(((i)>>2)*4096+((i)&3)*1024)); vhi[i]=vtr(vp_+(((i)>>2)*4096+((i)&3)*1024+512)); }while(0)
  #define KRD(G,j) do{ if(G){ kload2(kf,kp0+sl_next,j); SBAR(); } }while(0)
  #define STEP(C0,C1,P0,P1,t,GK,GV,GL) do{ SBAR(); \
    const lds_cptr vp_=vp0+sl_prev; \
    VRD(0); SBAR(); float sacc=(P0[0]+P0[1]); \
    GAPA(C0=__builtin_amdgcn_mfma_f32_32x32x16_bf16(kf[0],qr[0],negm,0,0,0), P0[2],P0[3],P0[4],P0[5],     pw0[0]=PKW(P0,0), pw0[1]=PKW(P0,2), pw0); \
    VRD(4); SBAR(); GAPA(C1=__builtin_amdgcn_mfma_f32_32x32x16_bf16(kf[1],qr[0],negm,0,0,0), P0[6],P0[7],P0[8],P0[9],     pw0[2]=PKW(P0,4), pw0[3]=PKW(P0,6), pw0); \
    VRD(1); SBAR(); GAPA(C0=__builtin_amdgcn_mfma_f32_32x32x16_bf16(kf[2],qr[1],C0,0,0,0),   P0[10],P0[11],P0[12],P0[13], pw1[0]=PKW(P0,8), pw1[1]=PKW(P0,10), pw1); \
    VRD(5); SBAR(); GAPA(C1=__builtin_amdgcn_mfma_f32_32x32x16_bf16(kf[3],qr[1],C1,0,0,0),   P0[14],P0[15],P1[0],P1[1],   pw1[2]=PKW(P0,12),pw1[3]=PKW(P0,14), pw1); \
    VRD(2); SBAR(); GAPA(C0=__builtin_amdgcn_mfma_f32_32x32x16_bf16(kf[4],qr[2],C0,0,0,0),   P1[2],P1[3],P1[4],P1[5],     pw2[0]=PKW(P1,0), pw2[1]=PKW(P1,2), pw2); \
    VRD(6); SBAR(); GAPA(C1=__builtin_amdgcn_mfma_f32_32x32x16_bf16(kf[5],qr[2],C1,0,0,0),   P1[6],P1[7],P1[8],P1[9],     pw2[2]=PKW(P1,4), pw2[3]=PKW(P1,6), pw2); \
    VRD(3); SBAR(); GAPA(C0=__builtin_amdgcn_mfma_f32_32x32x16_bf16(kf[6],qr[3],C0,0,0,0),   P1[10],P1[11],P1[12],P1[13], pw3[0]=PKW(P1,8), pw3[1]=PKW(P1,10), pw3); \
    VRD(7); SBAR(); GAPA(C1=__builtin_amdgcn_mfma_f32_32x32x16_bf16(kf[7],qr[3],C1,0,0,0),   P1[14],P1[15],0.f,0.f,       pw3[2]=PKW(P1,12),pw3[3]=PKW(P1,14), pw3); \
    l_reg+=sacc; \
    if(GK){DMA_K((t)+3,sl_cur);} if(GV){DMA_V((t)+1,sl_next);} \
    CMASK(C0,C1,t); \
    { float a=MX3(C0[0],C0[1],C1[0]),b=MX3(C0[2],C0[3],C1[1]); a=MX3(a,C1[2],C1[3]); \
      _Pragma("unroll") for(int r=4;r<16;r+=4){a=MX3(a,C0[r],C0[r+1]);b=MX3(b,C0[r+2],C0[r+3]);a=MX3(a,C1[r],C1[r+1]);b=MX3(b,C1[r+2],C1[r+3]);} \
      float rm=__builtin_fmaxf(a,b); { auto rr=__builtin_amdgcn_permlane32_swap(__float_as_uint(rm),__float_as_uint(rm),false,false); rm=__builtin_fmaxf(__uint_as_float(rr[0]),__uint_as_float(rr[1])); } \
      resc=false; \
      if(__builtin_expect(__any(rm>(float)THRL),0)){ const float dl=__builtin_fmaxf(rm,0.f); mhat+=dl; \
        _Pragma("unroll") for(int r=0;r<16;++r){C0[r]-=dl;C1[r]-=dl;} \
        _Pragma("unroll") for(int r=0;r<16;++r)negm[r]=-mhat; asm volatile("":"+v"(negm)); \
        const float f=__builtin_amdgcn_exp2f(-dl); l_reg*=f; if(hi==0)wsf[r32]=f; resc=true; } } \
    SBAR(); \
    GAPB(o[0]=__builtin_amdgcn_mfma_f32_32x32x16_bf16(PAF(0),VFR(0),o[0],0,0,0), C0,0); \
    GAPB(o[1]=__builtin_amdgcn_mfma_f32_32x32x16_bf16(PAF(0),VFR(4),o[1],0,0,0), C0,4); \
    KRD(GL,0); GAPB(o[0]=__builtin_amdgcn_mfma_f32_32x32x16_bf16(PAF(1),VFR(1),o[0],0,0,0), C0,8); \
    KRD(GL,1); GAPB(o[1]=__builtin_amdgcn_mfma_f32_32x32x16_bf16(PAF(1),VFR(5),o[1],0,0,0), C0,12); \
    KRD(GL,2); GAPB(o[0]=__builtin_amdgcn_mfma_f32_32x32x16_bf16(PAF(2),VFR(2),o[0],0,0,0), C1,0); \
    KRD(GL,3); GAPB(o[1]=__builtin_amdgcn_mfma_f32_32x32x16_bf16(PAF(2),VFR(6),o[1],0,0,0), C1,4); \
    GAPB(o[0]=__builtin_amdgcn_mfma_f32_32x32x16_bf16(PAF(3),VFR(3),o[0],0,0,0), C1,8); \
    GAPB(o[1]=__builtin_amdgcn_mfma_f32_32x32x16_bf16(PAF(3),VFR(7),o[1],0,0,0), C1,12); \
    }while(0)
  int t=1;
  #undef CMASK
  #define CMASK(P0,P1,t) do{ if((t)>=CTXT){ cmask(P0,P1,(TIX(t)-CTXT)*KVBLK-qpos+128,hi); } }while(0)
  #define ENDW(tt) do{ if((tt)+3<NT){WAIT_BAR(2);} else if((tt)+2<NT){WAIT_BAR(1);} else {WAIT_BAR(0);} }while(0)
  for(;t+1<NT;t+=2){
    STEP(pB0,pB1,pA0,pA1,t,(t+3<NT),(t+1<NT),(t+1<NT));       ENDW(t);   RESC(); ROT();
    STEP(pA0,pA1,pB0,pB1,t+1,(t+4<NT),(t+2<NT),(t+2<NT));     ENDW(t+1); RESC(); ROT();
  }
  STEP(pB0,pB1,pA0,pA1,NT-1,false,false,false); RESC();
  { float sacc=pB0[0]+pB0[1]; _Pragma("unroll") for(int r=2;r<16;++r)sacc+=pB0[r]; _Pragma("unroll") for(int r=0;r<16;++r)sacc+=pB1[r]; l_reg+=sacc;
    pw0=(u32x4){PKW(pB0,0),PKW(pB0,2),PKW(pB0,4),PKW(pB0,6)};pw1=(u32x4){PKW(pB0,8),PKW(pB0,10),PKW(pB0,12),PKW(pB0,14)};pw2=(u32x4){PKW(pB1,0),PKW(pB1,2),PKW(pB1,4),PKW(pB1,6)};pw3=(u32x4){PKW(pB1,8),PKW(pB1,10),PKW(pB1,12),PKW(pB1,14)};
    SBAR(); pv(o,vb0+sl_cur,PAF(0),PAF(1),PAF(2),PAF(3)); }
  #undef PKW
  #undef PAF
  #undef VFR
  #undef PIN
  #undef MX3
  #undef GAPA
  #undef GAPB
  #undef EX
  #undef VRD
  #undef KRD
  #undef STEP
  #undef ENDW
  {auto rr=__builtin_amdgcn_permlane32_swap(__float_as_uint(l_reg),__float_as_uint(l_reg),false,false);l_reg=__uint_as_float(rr[0])+__uint_as_float(rr[1]);}
  l_reg+=__builtin_amdgcn_exp2f(sink[hw]*1.4426950408889634f-mhat);
  if(hi==0)wsf[32+r32]=l_reg;asm volatile("s_waitcnt lgkmcnt(0)":::"memory");
  float rli[16];
  #pragma unroll
  for(int r=0;r<16;++r)rli[r]=__builtin_amdgcn_rcpf(wsf[32+crow(r,hi)]);
  bf16*Ow=O+(rowbase+q0+wq)*DM+hw*D;
  { bf16*stg=(bf16*)(shm+LDS_OST)+wid*2048;
    #pragma unroll
    for(int r=0;r<16;++r){const int orow=crow(r,hi);
      #pragma unroll
      for(int d0=0;d0<2;++d0)stg[orow*64+d0*32+r32]=__float2bfloat16(o[d0][r]*rli[r]);}
    asm volatile("s_waitcnt lgkmcnt(0)":::"memory");
    unsigned char*Ow8=(unsigned char*)O+((long)(rowbase+q0+wq)*DM+hw*D); (void)Ow;
    #pragma unroll
    for(int i=0;i<2;++i){const int row=i*16+(lane>>2),ch=lane&3; const u32x4 a=*(const u32x4*)(stg+row*64+ch*16),b=*(const u32x4*)(stg+row*64+ch*16+8); u32x4 w;
      w.x=pk4_fp8(PB_ASCALE*bflo(a.x),PB_ASCALE*bfhi(a.x),PB_ASCALE*bflo(a.y),PB_ASCALE*bfhi(a.y)); w.y=pk4_fp8(PB_ASCALE*bflo(a.z),PB_ASCALE*bfhi(a.z),PB_ASCALE*bflo(a.w),PB_ASCALE*bfhi(a.w));
      w.z=pk4_fp8(PB_ASCALE*bflo(b.x),PB_ASCALE*bfhi(b.x),PB_ASCALE*bflo(b.y),PB_ASCALE*bfhi(b.y)); w.w=pk4_fp8(PB_ASCALE*bflo(b.z),PB_ASCALE*bfhi(b.z),PB_ASCALE*bflo(b.w),PB_ASCALE*bfhi(b.w));
      ATTN_STORE16(Ow8+(long)row*DM+ch*16,w);} }
  asm volatile("s_waitcnt lgkmcnt(0)\n\ts_barrier":::"memory");
  #undef DMA_K
  #undef TIX
  #undef DMA_V
  #undef CMASK
  #undef START
  #undef RESC
  #undef ROT
}
constexpr int ATTN_LDS_BYTES=LDS_BYTES;
struct AttnTensors { const bf16* Q; const bf16* K; const bf16* V; bf16* O; const float* sink; };
struct AttnUnit { int bh; int qb; };
struct StaticOrder {
  int na, blk;
  __device__ __forceinline__ explicit StaticOrder(int na_,int block):na(na_),blk(block){}
  __device__ __forceinline__ bool next(int i,AttnUnit&u)const{ if(blk>=na)return false; const int un=i*na+blk; if(un>=1024)return false; u.bh=un>>6; u.qb=un&63; return true; }
  __device__ __forceinline__ void a_ready(const AttnUnit&)const{}
  __device__ __forceinline__ void done(const AttnUnit&)const{}
};
template<class Sched,int THRL=8> __device__ __forceinline__ void attn_phase(char*lds,const AttnTensors&T,const Sched&S){
  AttnUnit u;
  for(int i=0;S.next(i,u);++i){ S.a_ready(u); attn_unit<THRL>(u.bh>>3,u.bh&7,u.qb,T.Q,T.K,T.V,T.O,T.sink,lds); S.done(u); }
}
#undef SBAR
#undef WAIT_BAR
}
#define GAS __attribute__((address_space(1)))
#define LAS __attribute__((address_space(3)))
typedef unsigned short bf16;
typedef unsigned v4u __attribute__((ext_vector_type(4)));
typedef float f32x4 __attribute__((ext_vector_type(4)));
typedef short bf16x8 __attribute__((ext_vector_type(8)));
typedef GAS unsigned gu32;
typedef GAS unsigned long long gu64;
#define RLX_AGENT __ATOMIC_RELAXED, __HIP_MEMORY_SCOPE_AGENT
#define LDS_WAIT() asm volatile("s_waitcnt lgkmcnt(0)" ::: "memory")
#define VM_WAIT() asm volatile("s_waitcnt vmcnt(0)" ::: "memory")
__device__ __forceinline__ unsigned long long rt() { return __builtin_amdgcn_s_memrealtime(); }
#define XB_TMO      128
#define XB_XCNT(j)  (256  + 64 * (j))
#define XB_XSUB(j)  (1280 + 64 * (j))
#define XB_XGEN(j)  (2304 + 64 * (j))
#define XB_TOP      3328
#define XB_TOPGEN   3392
#define XCD_BAR_WORDS 3456
#define XB_SPIN_CAP (1u << 18)

__device__ __forceinline__ unsigned xb_ld(unsigned* p)              { return __hip_atomic_load(p, __ATOMIC_RELAXED, __HIP_MEMORY_SCOPE_AGENT); }
__device__ __forceinline__ unsigned xb_add(unsigned* p, unsigned v) { return __hip_atomic_fetch_add(p, v, __ATOMIC_RELAXED, __HIP_MEMORY_SCOPE_AGENT); }
__device__ __forceinline__ unsigned xb_xcc_id() { return (unsigned)__builtin_amdgcn_s_getreg((3 << 11) | 20) & 0xFu; }
#define XB_SPIN(cond, bar) do { unsigned _sp = 0; while (cond) { __builtin_amdgcn_s_sleep(1); \
    if ((++_sp & 255u) == 0u) { if (xb_ld(&(bar)[XB_TMO])) break; if (_sp > XB_SPIN_CAP) { atomicAdd(&(bar)[XB_TMO], 1u); break; } } } } while (0)

struct XcdBarrier {
    unsigned* bar; unsigned x;
    volatile LAS unsigned* st;
};

__device__ __forceinline__ XcdBarrier xcd_barrier_post(unsigned* bar, volatile LAS unsigned* st) {
    XcdBarrier b; b.bar = bar; b.x = xb_xcc_id(); b.st = st;
    if (threadIdx.x == 0) (void)xb_add(&bar[XB_XCNT(b.x)], 1u);
    return b;
}
__device__ __forceinline__ void xcd_barrier_complete(unsigned* bar, unsigned x, unsigned& nloc, unsigned& nx) {
    const unsigned G = gridDim.x * gridDim.y * gridDim.z;
    unsigned sum, cnt, mine, sp = 0u;
    for (;;) {
        sum = 0u; cnt = 0u; mine = 0u;
#pragma unroll
        for (unsigned j = 0; j < 16; ++j) { const unsigned c = xb_ld(&bar[XB_XCNT(j)]); sum += c; cnt += (c > 0u) ? 1u : 0u; mine = (j == x) ? c : mine; }
        if (sum == G) break;
        __builtin_amdgcn_s_sleep(1);
        if ((++sp & 255u) == 0u) { if (xb_ld(&bar[XB_TMO])) break; if (sp > XB_SPIN_CAP) { atomicAdd(&bar[XB_TMO], 1u); break; } }
    }
    nloc = mine > 0u ? mine : 1u; nx = cnt > 0u ? cnt : 1u;
}

__device__ __forceinline__ void xcd_barrier(const XcdBarrier& b) {
    asm volatile("s_waitcnt vmcnt(0)" ::: "memory");
    __syncthreads();
    if (threadIdx.x == 0) {
        unsigned* bar = b.bar;
        __builtin_amdgcn_s_waitcnt(0);
        unsigned nloc = b.st[0], nx = b.st[1];
        if (nloc == 0u) { xcd_barrier_complete(bar, b.x, nloc, nx); b.st[0] = nloc; b.st[1] = nx; }
        const unsigned old = xb_add(&bar[XB_XSUB(b.x)], 1u);
        const unsigned gen = old / nloc;
        if (old + 1u == (gen + 1u) * nloc) {
            __builtin_amdgcn_fence(__ATOMIC_RELEASE, "agent");
            asm volatile("s_waitcnt vmcnt(0)" ::: "memory");
            const unsigned og = xb_add(&bar[XB_TOP], 1u);
            const unsigned tg = og / nx;
            if (og + 1u == (tg + 1u) * nx) xb_add(&bar[XB_TOPGEN], 1u);
            else XB_SPIN(xb_ld(&bar[XB_TOPGEN]) == tg, bar);
            __builtin_amdgcn_fence(__ATOMIC_ACQUIRE, "agent");
            xb_add(&bar[XB_XGEN(b.x)], 1u);
            asm volatile("s_waitcnt vmcnt(0)" ::: "memory");
        } else {
            XB_SPIN(xb_ld(&bar[XB_XGEN(b.x)]) == gen, bar);
            __builtin_amdgcn_fence(__ATOMIC_ACQUIRE, "agent");
            asm volatile("s_waitcnt vmcnt(0)" ::: "memory");
        }
    }
    __syncthreads();
}
constexpr int NWAVES = 8;
#ifndef MK_N_LAUNCHES
#define MK_N_LAUNCHES 1
#endif
constexpr int N_PHASES = 10;
constexpr int N_LAUNCHES = MK_N_LAUNCHES;

constexpr int BATCH = 2, SEQ = 8192, D = 1024, CTXL = 256, NEXP = 32, TOPK = 4, DFF = 1024, INW = 4608;
constexpr int M = BATCH * SEQ;
constexpr int MC = BATCH * CTXL;
constexpr float NORM_EPS = 1e-5f;

constexpr size_t MiB = 1u << 20;
constexpr size_t WS_CTL = 0, CTL_ZERO_BYTES = 1 * MiB;
constexpr size_t WS_MOD = 1 * MiB;
constexpr size_t WS_WIN = 2 * MiB, WS_WAB = 11 * MiB, WS_WPL = 13 * MiB, WS_WOUT = 15 * MiB;
constexpr size_t WS_XN = 18 * MiB;
constexpr size_t WS_Q = 52 * MiB, WS_KX = 84 * MiB, WS_VX = 93 * MiB;
constexpr size_t WS_U = 102 * MiB, WS_SA = 134 * MiB, WS_SP = 166 * MiB, WS_AO = 198 * MiB, WS_DIFF = 230 * MiB, WS_MRG = 262 * MiB, WS_H2 = 294 * MiB;
constexpr size_t WS_LIST = 326 * MiB, WS_GW = 328 * MiB;
constexpr size_t WS_WGU = 330 * MiB, WS_WD = 458 * MiB;
constexpr size_t WS_WPBT = 420 * MiB, WS_WP16 = 423 * MiB;
constexpr size_t WS_WIN8 = 394 * MiB, WS_XN8 = 400 * MiB;
constexpr size_t WS_ACT = 522 * MiB, WS_Y2 = 666 * MiB, WS_END = 794 * MiB;
constexpr int CW_TMO = 0, CW_CODE = 1;
constexpr int CW_BAR = 4096;
constexpr int CW_ADA = 64;
constexpr int CW_GCNT = 16384;
constexpr int CW_PANEL = 32768;

constexpr int RING_OFF = 0, RING_BYTES = 131072;
constexpr int LDSCTL_OFF = RING_BYTES, MISC_OFF = LDSCTL_OFF + 320;
constexpr int XTRA_OFF = LDSCTL_OFF + 1024;
constexpr int LDS_BYTES = 147456;

__constant__ float ROPE_INVF[16] = {1.0f, 0.5623413324356079f, 0.3162277638912201f, 0.17782793939113617f, 0.10000000149011612f, 0.05623413249850273f, 0.03162277489900589f, 0.017782794311642647f,
    0.009999999776482582f, 0.005623413249850273f, 0.003162277629598975f, 0.0017782794311642647f, 0.0010000000474974513f, 0.000562341301701963f, 0.0003162277571391314f, 0.00017782794020604342f};

struct Frame {
    LAS unsigned char* lds;
    volatile LAS unsigned* MISC;
    gu32* ctl;
    int tid, lane, wave;
    int vcu, G;
    const float *x, *c, *ctx, *c_ctx, *w_ada, *b_ada, *n1g, *n2g, *w_in, *b_in, *sink, *w_pool, *pscale, *w_ab, *w_pb, *w_out, *w_router, *b_router, *w_gu, *b_gu, *w_down, *b_down, *final_g;
    float* out; float* out2; gu32* gcnt;
    float *modx, *modc, *ropec, *ropes, *GW;
    bf16 *WpbT, *Wp16; bf16 *Win_t, *Wab_t, *Wpl_t, *Wout_t; unsigned char *Wgu8, *Wd8, *H28, *ACT8, *Win8, *XN8;
    bf16 *XN, *Q, *KX, *VX, *U, *SA, *SP, *AO, *DIFF, *MRG; unsigned char* Y2;
    int* LIST;
};

__device__ __forceinline__ float wave_sum(float v) {
#pragma unroll
    for (int o = 1; o < 64; o <<= 1) v += __shfl_xor(v, o);
    return v;
}
__device__ __forceinline__ float wave_max(float v) {
#pragma unroll
    for (int o = 1; o < 64; o <<= 1) v = fmaxf(v, __shfl_xor(v, o));
    return v;
}
__device__ __forceinline__ int wave_min_i(int v) {
#pragma unroll
    for (int o = 1; o < 64; o <<= 1) { const int t = __shfl_xor(v, o); v = t < v ? t : v; }
    return v;
}
__device__ __forceinline__ void p0_transpose_item(const float* W, int K, int N, bf16* WT, int k0, int n0, int drow0, LAS float* scr, int lane, int wk0, const float* rowscale) {
#pragma unroll 8
    for (int i = 0; i < 32; ++i) { const int kk = 2 * i + (lane >> 5); scr[kk * 33 + (lane & 31)] = W[(size_t)(wk0 + kk) * N + n0 + (lane & 31)] * rowscale[kk]; }
    LDS_WAIT(); asm volatile("" ::: "memory");
    const int c = lane & 7;
#pragma unroll
    for (int j = 0; j < 4; ++j) { const int n = (lane >> 3) + 8 * j; const LAS float* s = scr + (8 * c) * 33 + n;
        v4u o; o.x = pk2(s[0 * 33], s[1 * 33]); o.y = pk2(s[2 * 33], s[3 * 33]); o.z = pk2(s[4 * 33], s[5 * 33]); o.w = pk2(s[6 * 33], s[7 * 33]);
        *(GAS v4u*)(WT + (size_t)(drow0 + n) * K + k0 + 8 * c) = o; }
    LDS_WAIT(); asm volatile("" ::: "memory");
}
__device__ __forceinline__ float fsilu(float v) { return v / (1.0f + __expf(-v)); }

constexpr int CVT_NITEMS = 16 * 144 + 16 * 32 + 16 * 32 + 32 * 16 * 64 + 32 * 16 * 32;
#ifndef P0_EXTRA
#define P0_EXTRA 3
#endif
#ifndef CVT_CAP7
#define CVT_CAP7 70
#endif
#ifndef CVT_SLOT2
#define CVT_SLOT2 16288
#endif
#ifndef CVT_G8
#define CVT_G8 180
#endif
#ifndef CVT_G3
#define CVT_G3 205
#endif
#ifndef CVT_SLOT3
#define CVT_SLOT3 13056
#endif
#ifndef CVT_SLOT7
#define CVT_SLOT7 7840
#endif
__device__ __forceinline__ void convert_items(Frame& F, int it0, int itend, int istride) {
    const int lane = F.lane;
    LAS float* scr = (LAS float*)(F.lds + RING_OFF + F.wave * 16384);
    constexpr int I_IN = 16 * 144, I_AB = 16 * 32, I_OUT = 16 * 32, I_GU = 32 * 16 * 64, I_D = 32 * 16 * 32;
    constexpr int NITEMS = I_IN + I_AB + I_OUT + I_GU + I_D;
#define P0_DECODE(it_, SRC, DST, NN, F8) do { int r = (it_); F8 = 0; \
        if (r < I_IN) { const int kb = r / 144, nb = r % 144, n0_ = 32 * nb; NN = INW; SRC = F.w_in + (size_t)(64 * kb) * INW + n0_;   \
            if (n0_ >= 1536 && n0_ < 2560) { DST = (unsigned char*)(F.Win_t + (size_t)n0_ * 1024 + 64 * kb); } else { F8 = 1; const int g_ = n0_ - 2560;   \
                const int dr_ = n0_ < 2560 ? n0_ : (g_ < 1024 ? 2560 + 256 * (g_ >> 7) + (g_ & 127) : 2560 + 256 * ((g_ - 1024) >> 7) + 128 + ((g_ - 1024) & 127)); DST = F.Win8 + (size_t)dr_ * 1024 + 64 * kb; } break; } r -= I_IN; \
        if (r < I_AB) { const int kb = r / 32, nb = r % 32; NN = 1024; SRC = F.w_ab + (size_t)(64 * kb) * 1024 + 32 * nb; F8 = 1; DST = (unsigned char*)F.Wab_t + (size_t)(32 * nb) * 1024 + 64 * kb; break; }     r -= I_AB; \
        if (r < I_OUT) { const int kb = r / 32, nb = r % 32; NN = 1024; SRC = F.w_out + (size_t)(64 * kb) * 1024 + 32 * nb; F8 = 1; DST = (unsigned char*)F.Wout_t + (size_t)(32 * nb) * 1024 + 64 * kb; break; }     r -= I_OUT; \
        F8 = 1; \
        if (r < I_GU) { const int e = r >> 10, rr = r & 1023, kb = rr >> 6, nb = rr & 63; const int n0 = 32 * nb; \
            const int d0 = (n0 < 1024) ? (256 * (n0 >> 7) + (n0 & 127)) : (256 * ((n0 - 1024) >> 7) + 128 + ((n0 - 1024) & 127));   \
            NN = 2048; SRC = F.w_gu + (size_t)e * 1024 * 2048 + (size_t)(64 * kb) * 2048 + n0; DST = F.Wgu8 + (size_t)e * 2048 * 1024 + (size_t)d0 * 1024 + 64 * kb; break; } r -= I_GU; \
        { const int e = r >> 9, rr = r & 511, kb = rr >> 5, nb = rr & 31; NN = 1024; SRC = F.w_down + (size_t)e * 1024 * 1024 + (size_t)(64 * kb) * 1024 + 32 * nb; DST = F.Wd8 + (size_t)e * 1024 * 1024 + (size_t)(32 * nb) * 1024 + 64 * kb; } } while (0)
#ifdef P0_NT_ST
#define P0_ST(p, v) __builtin_nontemporal_store((v), (p))
#else
#define P0_ST(p, v) (*(p) = (v))
#endif
#ifndef P0_NO_NT
#define P0_LD(p) __builtin_nontemporal_load(p)
#define P0_LD4(p) __builtin_nontemporal_load(p)
#else
#define P0_LD(p) (*(p))
#define P0_LD4(p) (*(p))
#endif
    {
        int it = it0; const float* src = nullptr; unsigned char* dst = nullptr; int NN = 0, f8 = 0; float v[32];
        if (it < itend) { P0_DECODE(it, src, dst, NN, f8);
#pragma unroll
            for (int i = 0; i < 8; ++i) { const f32x4 q_ = P0_LD4((const GAS f32x4*)(src + (size_t)(8 * i + (lane >> 3)) * NN + 4 * (lane & 7))); v[4 * i] = q_.x; v[4 * i + 1] = q_.y; v[4 * i + 2] = q_.z; v[4 * i + 3] = q_.w; } }
        while (it < itend) {
#pragma unroll
            for (int i = 0; i < 32; ++i) scr[(8 * (i >> 2) + (lane >> 3)) * 33 + 4 * (lane & 7) + (i & 3)] = v[i];
            unsigned char* cdst = dst; const int cf8 = f8; it += istride;
            if (it < itend) { P0_DECODE(it, src, dst, NN, f8);
#pragma unroll
                for (int i = 0; i < 8; ++i) { const f32x4 q_ = P0_LD4((const GAS f32x4*)(src + (size_t)(8 * i + (lane >> 3)) * NN + 4 * (lane & 7))); v[4 * i] = q_.x; v[4 * i + 1] = q_.y; v[4 * i + 2] = q_.z; v[4 * i + 3] = q_.w; } }
            LDS_WAIT(); asm volatile("" ::: "memory");
            if (cf8) {
                const int c = lane & 3;
#pragma unroll
                for (int j = 0; j < 2; ++j) { const int n = (lane >> 2) + 16 * j; const LAS float* sp = scr + (16 * c) * 33 + n;
                    v4u o;
                    o.x = pk4_fp8(MOE_WSCALE * sp[0 * 33], MOE_WSCALE * sp[1 * 33], MOE_WSCALE * sp[2 * 33], MOE_WSCALE * sp[3 * 33]); o.y = pk4_fp8(MOE_WSCALE * sp[4 * 33], MOE_WSCALE * sp[5 * 33], MOE_WSCALE * sp[6 * 33], MOE_WSCALE * sp[7 * 33]);
                    o.z = pk4_fp8(MOE_WSCALE * sp[8 * 33], MOE_WSCALE * sp[9 * 33], MOE_WSCALE * sp[10 * 33], MOE_WSCALE * sp[11 * 33]); o.w = pk4_fp8(MOE_WSCALE * sp[12 * 33], MOE_WSCALE * sp[13 * 33], MOE_WSCALE * sp[14 * 33], MOE_WSCALE * sp[15 * 33]);
                    P0_ST((GAS v4u*)(cdst + (size_t)n * 1024 + 16 * c), o); }
            } else {
                const int c = lane & 7;
#pragma unroll
                for (int j = 0; j < 4; ++j) { const int n = (lane >> 3) + 8 * j; const LAS float* sp = scr + (8 * c) * 33 + n;
                    v4u o; o.x = pk2(sp[0 * 33], sp[1 * 33]); o.y = pk2(sp[2 * 33], sp[3 * 33]); o.z = pk2(sp[4 * 33], sp[5 * 33]); o.w = pk2(sp[6 * 33], sp[7 * 33]);
                    P0_ST((GAS v4u*)((bf16*)cdst + (size_t)n * 1024 + 8 * c), o); }
            }
            LDS_WAIT(); asm volatile("" ::: "memory");
        }
    }
#undef P0_DECODE
}
__device__ __forceinline__ void pool_fold(Frame& F, int gt0, int gts);
#ifdef TSA
#define P0_TS(id) do { if ((id) == TSA && F.tid == 0) *(volatile LAS unsigned long long*)(F.lds + 146432) = __builtin_amdgcn_s_memrealtime(); if ((id) == TSB && F.tid == 0) *(volatile LAS unsigned long long*)(F.lds + 146440) = __builtin_amdgcn_s_memrealtime(); } while (0)
#else
#define P0_TS(id) do {} while (0)
#endif
__device__ __forceinline__ void p0_prologue(Frame& F) {
    const int gw = F.vcu * NWAVES + F.wave, NGW = F.G * NWAVES, lane = F.lane;
#ifdef ADA_REP
    for (int rep2_ = 0; rep2_ < 2; ++rep2_)
#endif
    for (int it = gw; it < 1536; it += NGW) {
        const int n0 = 4 * it; const bool wantc = n0 < 2048;
        f32x4 a0 = {0.f, 0.f, 0.f, 0.f}, a1 = a0, a2 = a0;
        f32x4 wv[16];
#pragma unroll
        for (int j = 0; j < 16; ++j) wv[j] = *(const GAS f32x4*)(F.w_ada + (size_t)(lane + 64 * j) * 6144 + n0);
#pragma unroll
        for (int j = 0; j < 16; ++j) { const int k = lane + 64 * j; const f32x4 w = wv[j];
            a0 += fsilu(F.c[k]) * w; a1 += fsilu(F.c[1024 + k]) * w; a2 += fsilu(F.c_ctx[k]) * w; }
#pragma unroll
        for (int i = 0; i < 4; ++i) { a0[i] = wave_sum(a0[i]); a1[i] = wave_sum(a1[i]); a2[i] = wave_sum(a2[i]); }
        if (lane == 0) { const f32x4 bb = *(const f32x4*)(F.b_ada + n0);
            const f32x4 r0 = a0 + bb, r1 = a1 + bb, r2 = a2 + bb;
#define ST8(p, lo_, hi_) __hip_atomic_store((gu64*)(p), ((unsigned long long)__float_as_uint(hi_) << 32) | __float_as_uint(lo_), RLX_AGENT)
            ST8(F.modx + n0, r0.x, r0.y); ST8(F.modx + n0 + 2, r0.z, r0.w); ST8(F.modx + 6144 + n0, r1.x, r1.y); ST8(F.modx + 6144 + n0 + 2, r1.z, r1.w);
            if (wantc) { ST8(F.modc + n0, r2.x, r2.y); ST8(F.modc + n0 + 2, r2.z, r2.w); }
#undef ST8
            asm volatile("s_waitcnt vmcnt(0)" ::: "memory");
            __hip_atomic_fetch_add(F.ctl + CW_ADA, 1u, RLX_AGENT); }
    }
    P0_TS(22);
    {
        for (int idx = (NGW - 1 - gw) * 64 + lane; idx < 3072; idx += NGW * 64) {
            const int ti = idx >> 4, p = idx & 15; const float pos = (float)(ti < 128 ? ti : ti - 128);
            const float angf = pos * ROPE_INVF[p];
            const double a = (double)angf; const double n = __builtin_rint(a * 0.63661977236758134308); const double r = __builtin_fma(-n, 6.123233995736766e-17, __builtin_fma(-n, 1.5707963267948966, a));
            const double r2 = r * r;
            double sp = -7.6471637318198164759e-13; sp = sp * r2 + 1.6059043836821614599e-10; sp = sp * r2 - 2.5052108385441718775e-8; sp = sp * r2 + 2.7557319223985890653e-6; sp = sp * r2 - 1.9841269841269841270e-4; sp = sp * r2 + 8.3333333333333333333e-3; sp = sp * r2 - 1.6666666666666666667e-1; const double sn = r + r * r2 * sp;
            double cp = 4.7794773323873852974e-14; cp = cp * r2 - 1.1470745597729724714e-11; cp = cp * r2 + 2.0876756987868098979e-9; cp = cp * r2 - 2.7557319223985890653e-7; cp = cp * r2 + 2.4801587301587301587e-5; cp = cp * r2 - 1.3888888888888888889e-3; cp = cp * r2 + 4.1666666666666666667e-2; cp = cp * r2 - 0.5; const double cs = 1.0 + r2 * cp;
            const int q = ((int)n) & 3; double co, si;
            if (q == 0) { co = cs; si = sn; } else if (q == 1) { co = -sn; si = cs; } else if (q == 2) { co = -cs; si = -sn; } else { co = sn; si = -cs; }
            F.ropec[idx] = (float)co; F.ropes[idx] = (float)si;
        }
    }
    P0_TS(23);
    { constexpr int n0 = CVT_NITEMS - CVT_SLOT2 - CVT_SLOT7 - CVT_SLOT3; const int nfree = NGW - 1536 - 48; const int ex = (NGW == 2048) ? nfree * P0_EXTRA : 0;
      if (ex > 0 && gw >= 1536 && gw < NGW - 48) convert_items(F, gw - 1536, ex, nfree);
      convert_items(F, ex + gw, n0, NGW); }
    P0_TS(24);
#ifdef CVT_REP
    convert_items(F, gw, CVT_NITEMS - CVT_SLOT2 - CVT_SLOT7 - CVT_SLOT3, NGW);
#endif
    { LAS float* scr2 = (LAS float*)(F.lds + RING_OFF + F.wave * 16384);
      for (int it = (NGW == 2048 ? gw - 1536 + (gw < 1536 ? 4096 : 0) : gw); it < 16 * 32; it += NGW) { const int jb = it >> 5,     nb = it & 31, g = jb >> 2, j0 = 64 * (jb & 3);
          p0_transpose_item(F.w_pb, 256, 1024, F.WpbT, j0, 32 * nb, g * 1024 + 32 * nb, scr2, lane, 64 * jb, F.pscale + 64 * jb); }
      for (int i = F.vcu * (NWAVES * 64) + F.tid; i < 4 * 256 * 256 / 4; i += F.G * NWAVES * 64) { const f32x4 w = *(const GAS f32x4*)(F.w_pool + 4 * (size_t)i);
          *((GAS unsigned long long*)F.Wp16 + i) = (unsigned long long)pk2(w.x, w.y) | ((unsigned long long)pk2(w.z, w.w) << 32); } }
#ifdef FOLD_REP
    pool_fold(F, F.vcu * (NWAVES * 64) + F.tid, F.G * NWAVES * 64);
#endif
#ifdef STRIDE_PROBE
    {
        float accd = 0.f;
        for (int it = gw; it < 32 * 1024; it += NGW) { const int e = it >> 10, rr = it & 1023, kb = rr >> 6, nb = rr & 63;
            const float* src = F.w_gu + (size_t)e * 1024 * 2048 + (size_t)(64 * kb) * 2048 + 32 * nb; float v[32];
#pragma unroll
            for (int i = 0; i < 32; ++i) v[i] = __builtin_nontemporal_load(src + (size_t)(2 * i + (lane >> 5)) * 2048 + (lane & 31));
#pragma unroll
            for (int i = 0; i < 32; ++i) accd += v[i]; }
        if (accd == 1234.5f) F.GW[0] = 1.f;
    }
#endif
#ifdef STREAM_PROBE
    {
        const GAS f32x4* p = (const GAS f32x4*)F.w_gu; f32x4 acc4 = {0.f, 0.f, 0.f, 0.f};
        for (size_t i = (size_t)(F.vcu * NWAVES + F.wave) * 64 + lane; i < (size_t)32 * 1024 * 2048 / 4; i += (size_t)F.G * NWAVES * 64 * 4) {
            const f32x4 v0 = __builtin_nontemporal_load(p + i), v1 = __builtin_nontemporal_load(p + i + (size_t)F.G * NWAVES * 64), v2 = __builtin_nontemporal_load(p + i + (size_t)F.G * NWAVES * 128), v3 = __builtin_nontemporal_load(p + i + (size_t)F.G * NWAVES * 192);
            acc4 += v0 + v1 + v2 + v3; }
        if (acc4.x + acc4.y + acc4.z + acc4.w == 1234.5f) F.GW[0] = 1.f;
    }
#endif
}
__device__ __forceinline__ void pool_fold(Frame& F, int gt0, int gts) {
    LAS float* wl = (LAS float*)(F.lds + RING_OFF + F.wave * 16384);
    const int lane = F.lane;
    for (int gt = gt0; gt < 1024 * 128; gt += gts) {
        const int n = gt & 1023, kg = __builtin_amdgcn_readfirstlane(gt >> 10), k0 = 8 * kg, g = k0 >> 8;
        const float* wp = F.w_pool + (size_t)k0 * 256;
#pragma unroll
        for (int q = 0; q < 8; ++q) *(LAS f32x4*)(wl + 4 * (lane + 64 * q)) = *(const GAS f32x4*)(wp + 4 * (lane + 64 * q));
        LDS_WAIT(); asm volatile("" ::: "memory");
        float a[8];
#pragma unroll
        for (int i = 0; i < 8; ++i) a[i] = 0.f;
#pragma unroll 2
        for (int j4 = 0; j4 < 64; ++j4) {
            float bsc[4];
#pragma unroll
            for (int jj = 0; jj < 4; ++jj) bsc[jj] = F.pscale[256 * g + 4 * j4 + jj] * F.w_pb[(size_t)(256 * g + 4 * j4 + jj) * 1024 + n];
#pragma unroll
            for (int i = 0; i < 8; ++i) { const f32x4 w = *(const LAS f32x4*)(wl + i * 256 + 4 * j4); a[i] += (w.x * bsc[0] + w.y * bsc[1]) + (w.z * bsc[2] + w.w * bsc[3]); }
        }
        *(GAS unsigned long long*)((GAS unsigned char*)F.Wpl_t + (size_t)n * 1024 + k0) = (unsigned long long)pk4_fp8(MOE_WSCALE * a[0], MOE_WSCALE * a[1], MOE_WSCALE * a[2], MOE_WSCALE * a[3]) | ((unsigned long long)pk4_fp8(MOE_WSCALE * a[4], MOE_WSCALE * a[5], MOE_WSCALE * a[6], MOE_WSCALE * a[7]) << 32);
        LDS_WAIT(); asm volatile("" ::: "memory");
    }
}
__device__ __forceinline__ void p1_row(Frame& F, int m, const f32x4 (&v)[4], int lane) {
    const float *sh, *sc;
    if (m < M) { sh = F.modx + (m >> 13) * 6144; sc = sh + 1024; } else { sh = F.modc; sc = F.modc + 1024; }
    float s = 0.f;
#pragma unroll
    for (int j = 0; j < 4; ++j) s += (v[j].x * v[j].x + v[j].y * v[j].y) + (v[j].z * v[j].z + v[j].w * v[j].w);
    const float rstd = 1.0f / sqrtf(wave_sum(s) * (1.f / D) + NORM_EPS);
    GAS unsigned long long* o8 = (GAS unsigned long long*)(F.XN + (size_t)m * D) + lane; GAS unsigned* o4 = (GAS unsigned*)(F.XN8 + (size_t)m * D) + lane;
#pragma unroll
    for (int j = 0; j < 4; ++j) { const int c0 = 4 * lane + 256 * j;
        const f32x4 g = *(const f32x4*)(F.n1g + c0), a = *(const f32x4*)(sc + c0), h = *(const f32x4*)(sh + c0);
        const f32x4 y = (v[j] * rstd) * g * (a + 1.0f) + h;
        if (m < M) o8[64 * j] = (unsigned long long)pk2(y.x, y.y) | ((unsigned long long)pk2(y.z, y.w) << 32);
        o4[64 * j] = pk4_fp8(y.x, y.y, y.z, y.w); }
}
__device__ __forceinline__ void p1_norm_mod(Frame& F, bool wait_ada) {
    const int gw = F.vcu * NWAVES + F.wave, NGW = F.G * NWAVES, lane = F.lane;
    if (wait_ada) {
        unsigned sp = 0; while (__hip_atomic_load(F.ctl + CW_ADA, RLX_AGENT) < 1536u) { __builtin_amdgcn_s_sleep(2); if (++sp > (1u << 22)) break; }
        __builtin_amdgcn_fence(__ATOMIC_ACQUIRE, "agent"); asm volatile("s_waitcnt vmcnt(0)" ::: "memory");
    }
    for (int m = gw; m < M + MC; m += 2 * NGW) {
        const int m2 = m + NGW; const bool two = m2 < M + MC;
        const float* r1 = (m < M) ? F.x + (size_t)m * D : F.ctx + (size_t)(m - M) * D;
        const float* r2 = !two ? r1 : ((m2 < M) ? F.x + (size_t)m2 * D : F.ctx + (size_t)(m2 - M) * D);
        f32x4 v1[4], v2[4];
#pragma unroll
        for (int j = 0; j < 4; ++j) v1[j] = __builtin_nontemporal_load((const GAS f32x4*)r1 + lane + 64 * j);
#pragma unroll
        for (int j = 0; j < 4; ++j) v2[j] = __builtin_nontemporal_load((const GAS f32x4*)r2 + lane + 64 * j);
        p1_row(F, m, v1, lane);
        if (two) p1_row(F, m2, v2, lane);
    }
}
template <int G_> __device__ __forceinline__ void pool_item(Frame& F, int m, int chunk) {
    constexpr int half = 1 << G_, W = 2 * half;
    const int l = m & (SEQ - 1);
    const bf16* base = F.U + (size_t)(m - l) * D + G_ * 256 + chunk * 8;
    v4u w[W];
#pragma unroll
    for (int i = 0; i < W; ++i) { int j = l - half + i; j = j < 0 ? 0 : (j > SEQ - 1 ? SEQ - 1 : j); w[i] = *(const GAS v4u*)(base + (size_t)j * D); }
    float s[8];
#pragma unroll
    for (int i = 0; i < 8; ++i) s[i] = 0.f;
    int cnt = 0;
#pragma unroll
    for (int i = 0; i < W; ++i) { const bool ok = (unsigned)(l - half + i) < (unsigned)SEQ; const float f = ok ? 1.f : 0.f; cnt += ok ? 1 : 0;
        s[0] += f * bflo(w[i].x); s[1] += f * bfhi(w[i].x); s[2] += f * bflo(w[i].y); s[3] += f * bfhi(w[i].y); s[4] += f * bflo(w[i].z); s[5] += f * bfhi(w[i].z); s[6] += f * bflo(w[i].w); s[7] += f * bfhi(w[i].w); }
    const v4u c = w[half]; const float inv = 1.0f / (float)cnt;
    const unsigned d0 = pk4_fp8(PB_ASCALE * (s[0] * inv - bflo(c.x)), PB_ASCALE * (s[1] * inv - bfhi(c.x)), PB_ASCALE * (s[2] * inv - bflo(c.y)), PB_ASCALE * (s[3] * inv - bfhi(c.y)));
    const unsigned d1 = pk4_fp8(PB_ASCALE * (s[4] * inv - bflo(c.z)), PB_ASCALE * (s[5] * inv - bfhi(c.z)), PB_ASCALE * (s[6] * inv - bflo(c.w)), PB_ASCALE * (s[7] * inv - bfhi(c.w)));
    *(GAS unsigned long long*)((GAS unsigned char*)F.DIFF + (size_t)m * D + G_ * 256 + chunk * 8) = (unsigned long long)d0 | ((unsigned long long)d1 << 32);
}
__device__ __forceinline__ void p3_pool_diff(Frame& F) {
    const int gw = F.vcu * NWAVES + F.wave, NGW = F.G * NWAVES;
    for (int wi = gw; wi < 4 * (M / 2); wi += NGW) {
        const int g = (wi + (wi >> 11)) & 3, m = 2 * (wi >> 2) + (F.lane >> 5), chunk = F.lane & 31;
        if (g == 0) pool_item<0>(F, m, chunk); else if (g == 1) pool_item<1>(F, m, chunk); else if (g == 2) pool_item<2>(F, m, chunk); else pool_item<3>(F, m, chunk);
    }
}
typedef short p6_bf16x8 __attribute__((ext_vector_type(8)));
__device__ __forceinline__ float half_max(float v) {
#pragma unroll
    for (int o = 1; o < 32; o <<= 1) v = fmaxf(v, __shfl_xor(v, o));
    return v;
}
__device__ __forceinline__ int half_min_i(int v) {
#pragma unroll
    for (int o = 1; o < 32; o <<= 1) { const int t = __shfl_xor(v, o); v = t < v ? t : v; }
    return v;
}
__device__ __forceinline__ f32x4 p6_x1(Frame& F, int row, int lane, int j) {
    const f32x4 xv = __builtin_nontemporal_load((const GAS f32x4*)(F.x + (size_t)row * D) + lane + 64 * j); const unsigned long long d = ((const GAS unsigned long long*)(F.XN + (size_t)row * D) + lane)[64 * j];
    return xv + (f32x4){bflo((unsigned)d), bfhi((unsigned)d), bflo((unsigned)(d >> 32)), bfhi((unsigned)(d >> 32))};
}
__device__ __forceinline__ void panel_wait(Frame& F, int bank, int pm);
__device__ __forceinline__ void p6_router(Frame& F, bool wait_panel) {
    LAS unsigned char* SH = F.lds + RING_OFF;
    LAS unsigned char* SL = SH + 32768;
    LAS float* PP = (LAS float*)(SH + 65536);
    volatile LAS int* CNTL = (volatile LAS int*)(F.lds + XTRA_OFF + 384); volatile LAS int* BASEL = CNTL + 32; volatile LAS int* ENT = CNTL + 64;
    const int tid = F.tid, lane = F.lane, wave = F.wave;
    const int tk = lane & 15, kq = lane >> 4;
    p6_bf16x8 Bh[4][2], Bl[4][2];
#pragma unroll
    for (int s = 0; s < 4; ++s)
#pragma unroll
        for (int eh = 0; eh < 2; ++eh) {
            unsigned hw[4], lw[4];
#pragma unroll
            for (int jj = 0; jj < 4; ++jj) {
                const int k = 128 * wave + 32 * s + 8 * kq + 2 * jj;
                const float w0 = F.w_router[(size_t)k * 32 + 16 * eh + tk], w1 = F.w_router[(size_t)(k + 1) * 32 + 16 * eh + tk];
                const unsigned h = pk2(w0, w1); hw[jj] = h; lw[jj] = pk2(w0 - bflo(h), w1 - bfhi(h));
            }
            Bh[s][eh] = __builtin_bit_cast(p6_bf16x8, (v4u){hw[0], hw[1], hw[2], hw[3]}); Bl[s][eh] = __builtin_bit_cast(p6_bf16x8, (v4u){lw[0], lw[1], lw[2], lw[3]});
        }
    const float brt = F.b_router[lane & 31];
    for (int rb = F.vcu; rb < M / 64; rb += F.G) {
        f32x4 nx[2][4];
#pragma unroll
        for (int r = 0; r < 2; ++r)
#pragma unroll
            for (int j = 0; j < 4; ++j) nx[r][j] = __builtin_nontemporal_load((const GAS f32x4*)(F.x + (size_t)(rb * 64 + 2 * wave + r) * D) + lane + 64 * j);
        if (wait_panel) panel_wait(F, 1, rb >> 2);
        if (tid < 32) CNTL[tid] = 0;
        const int b = (rb * 64) >> 13;
        f32x4 gs[4], hs[4];
        { const float* sh = F.modx + b * 6144 + 3072; const float* sc = sh + 1024;
#pragma unroll
          for (int j = 0; j < 4; ++j) { const int c0 = 4 * lane + 256 * j; gs[j] = *(const f32x4*)(F.n2g + c0) * (*(const f32x4*)(sc + c0) + 1.0f); hs[j] = *(const f32x4*)(sh + c0); } }
#pragma unroll
        for (int r = 0; r < 2; ++r)
#pragma unroll
            for (int j = 0; j < 4; ++j) { const unsigned long long d = ((const GAS unsigned long long*)(F.XN + (size_t)(rb * 64 + 2 * wave + r) * D) + lane)[64 * j];
                nx[r][j] += (f32x4){bflo((unsigned)d), bfhi((unsigned)d), bflo((unsigned)(d >> 32)), bfhi((unsigned)(d >> 32))}; }
#pragma unroll 1
        for (int tg = 0; tg < 4; ++tg) {
#pragma unroll
            for (int r = 0; r < 2; ++r) {
                const int trow = 2 * wave + r, row = rb * 64 + tg * 16 + trow;
                f32x4 h[4]; float ssq = 0.f;
#pragma unroll
                for (int j = 0; j < 4; ++j) { h[j] = nx[r][j]; ssq += (h[j].x * h[j].x + h[j].y * h[j].y) + (h[j].z * h[j].z + h[j].w * h[j].w); }
                if (tg < 3) {
#pragma unroll
                    for (int j = 0; j < 4; ++j) nx[r][j] = p6_x1(F, row + 16, lane, j);
                }
                const float rstd = 1.0f / sqrtf(wave_sum(ssq) * (1.f / D) + NORM_EPS);
                GAS unsigned* o4 = (GAS unsigned*)(F.H28 + (size_t)row * D) + lane;
#pragma unroll
                for (int j = 0; j < 4; ++j) {
                    h[j] = (h[j] * rstd) * gs[j] + hs[j];
                    o4[64 * j] = pk4_fp8(h[j].x, h[j].y, h[j].z, h[j].w);
                    const unsigned h01 = pk2(h[j].x, h[j].y), h23 = pk2(h[j].z, h[j].w);
                    const unsigned l01 = pk2(h[j].x - bflo(h01), h[j].y - bfhi(h01)), l23 = pk2(h[j].z - bflo(h23), h[j].w - bfhi(h23));
                    const int k = 4 * lane + 256 * j, c = k >> 3, off = trow * 2048 + ((c ^ trow) << 4) + ((k >> 2) & 1) * 8;
                    *(LAS unsigned long long*)(SH + off) = (unsigned long long)h01 | ((unsigned long long)h23 << 32);
                    *(LAS unsigned long long*)(SL + off) = (unsigned long long)l01 | ((unsigned long long)l23 << 32);
                }
            }
            __syncthreads();
            f32x4 a0 = {0.f, 0.f, 0.f, 0.f}, a1 = a0;
#pragma unroll
            for (int s = 0; s < 4; ++s) {
                const int c = 16 * wave + 4 * s + kq, off = tk * 2048 + ((c ^ tk) << 4);
                const p6_bf16x8 ah = *(const LAS p6_bf16x8*)(SH + off), al = *(const LAS p6_bf16x8*)(SL + off);
                a0 = __builtin_amdgcn_mfma_f32_16x16x32_bf16(ah, Bh[s][0], a0, 0, 0, 0); a0 = __builtin_amdgcn_mfma_f32_16x16x32_bf16(ah, Bl[s][0], a0, 0, 0, 0); a0 = __builtin_amdgcn_mfma_f32_16x16x32_bf16(al, Bh[s][0], a0, 0, 0, 0);
                a1 = __builtin_amdgcn_mfma_f32_16x16x32_bf16(ah, Bh[s][1], a1, 0, 0, 0); a1 = __builtin_amdgcn_mfma_f32_16x16x32_bf16(ah, Bl[s][1], a1, 0, 0, 0); a1 = __builtin_amdgcn_mfma_f32_16x16x32_bf16(al, Bh[s][1], a1, 0, 0, 0);
            }
#pragma unroll
            for (int r = 0; r < 4; ++r) { PP[(wave * 16 + 4 * kq + r) * 32 + tk] = a0[r]; PP[(wave * 16 + 4 * kq + r) * 32 + 16 + tk] = a1[r]; }
            __syncthreads();
            {
                const int trow = 2 * wave + (lane >> 5), e = lane & 31, row = rb * 64 + tg * 16 + trow, rl = tg * 16 + trow;
                float logit = brt;
#pragma unroll
                for (int v = 0; v < 8; ++v) logit += PP[(v * 16 + trow) * 32 + e];
                float tv[4]; int te[4];
#pragma unroll
                for (int k = 0; k < 4; ++k) { const float mx = half_max(logit); const int ix = half_min_i(logit == mx ? e : 99); tv[k] = mx; te[k] = ix; if (e == ix) logit = -INFINITY; }
                const float e1 = __expf(tv[1] - tv[0]), e2 = __expf(tv[2] - tv[0]), e3 = __expf(tv[3] - tv[0]); const float inv = 1.0f / (1.0f + e1 + e2 + e3);
                if (e < 4) { const float wk = (e == 0 ? 1.0f : e == 1 ? e1 : e == 2 ? e2 : e3) * inv; const int ek = e == 0 ? te[0] : e == 1 ? te[1] : e == 2 ? te[2] : te[3];
                    F.GW[(size_t)row * 4 + e] = wk;
                    const int ls = __hip_atomic_fetch_add((LAS int*)&CNTL[ek], 1, __ATOMIC_RELAXED, __HIP_MEMORY_SCOPE_WORKGROUP);
                    ENT[rl * 4 + e] = (ek << 16) | ls; }
            }
            __syncthreads();
        }
        if (tid < 32) BASEL[tid] = (int)__hip_atomic_fetch_add(F.gcnt + 64 * tid, (unsigned)CNTL[tid], __ATOMIC_RELAXED, __HIP_MEMORY_SCOPE_AGENT);
        __syncthreads();
        if (tid < 256) { const int en = ENT[tid], e = en >> 16, ls = en & 0xffff; F.LIST[e * 16384 + BASEL[e] + ls] = (rb * 64 + (tid >> 2)) * 4 + (tid & 3); }
        __syncthreads();
    }
}
__device__ __forceinline__ void moe_prefix(Frame& F) {
    volatile LAS int* PT = (volatile LAS int*)(F.lds + XTRA_OFF); volatile LAS int* CN = PT + 64;
    if (F.wave == 0) {
        const int e = F.lane & 31; const int c = (int)__hip_atomic_load(F.gcnt + 64 * e, RLX_AGENT); const int tiles = (c + 255) >> 8; int incl = tiles;
#pragma unroll
        for (int d = 1; d < 32; d <<= 1) { const int t = __shfl_up(incl, d, 64); if (e >= d) incl += t; }
        if (F.lane < 32) { CN[e] = c; PT[e] = incl - tiles; if (e == 31) PT[32] = incl; } }
    __syncthreads();
}
__device__ __forceinline__ void p9_final(Frame& F) {
    const int gw = F.vcu * NWAVES + F.wave, NGW = F.G * NWAVES, lane = F.lane;
    for (int m = gw; m < M; m += NGW) {
        const float* g2 = F.modx + (m >> 13) * 6144 + 5120;
        const f32x4 gwv = *(const f32x4*)(F.GW + (size_t)m * 4);
        f32x4 v[4]; float s = 0.f;
#pragma unroll
        for (int j = 0; j < 4; ++j) {
            f32x4 y = {0.f, 0.f, 0.f, 0.f};
#pragma unroll
            for (int k = 0; k < 4; ++k) { const int w = __builtin_nontemporal_load((const GAS int*)(F.Y2 + ((size_t)m * 4 + k) * D) + lane + 64 * j);
                const float gk = gwv[k] * (1.0f / Y2_SCALE); y.x += gk * __builtin_amdgcn_cvt_f32_fp8(w, 0); y.y += gk * __builtin_amdgcn_cvt_f32_fp8(w, 1); y.z += gk * __builtin_amdgcn_cvt_f32_fp8(w, 2); y.w += gk * __builtin_amdgcn_cvt_f32_fp8(w, 3); }
            const f32x4 g = *(const f32x4*)(g2 + 4 * lane + 256 * j);
            v[j] = p6_x1(F, m, lane, j) + g * y; s += (v[j].x * v[j].x + v[j].y * v[j].y) + (v[j].z * v[j].z + v[j].w * v[j].w);
        }
        const float rstd = 1.0f / sqrtf(wave_sum(s) * (1.f / D) + NORM_EPS);
#pragma unroll
        for (int j = 0; j < 4; ++j) { const f32x4 g = *(const f32x4*)(F.final_g + 4 * lane + 256 * j); ((GAS f32x4*)(F.out2 + (size_t)m * D) + lane)[64 * j] = (v[j] * rstd) * g; }
    }
}

__device__ __forceinline__ void panel_publish(Frame& F, int bank, int pm) {
    asm volatile("s_waitcnt vmcnt(0)" ::: "memory");
    if (F.lane == 0) __hip_atomic_fetch_add(F.ctl + CW_PANEL + bank * 8192 + 64 * pm, 1u, RLX_AGENT);
}
__device__ __forceinline__ void panel_wait(Frame& F, int bank, int pm) {
    if (F.wave == 0) { unsigned sp = 0; while ((unsigned)__builtin_amdgcn_readfirstlane((int)__hip_atomic_load(F.ctl + CW_PANEL + bank * 8192 + 64 * pm, RLX_AGENT)) < 32u) { __builtin_amdgcn_s_sleep(2); if (++sp > (1u << 21)) break; }
        __builtin_amdgcn_fence(__ATOMIC_ACQUIRE, "agent"); asm volatile("s_waitcnt vmcnt(0)" ::: "memory"); }
    __syncthreads();
}
struct Args { const float* in[23]; float* out; unsigned char* ws; int ph_lo, ph_hi, probe, pad; };
__global__ void __launch_bounds__(NWAVES * 64, 2) fwd_megakernel(Args args) {
    extern __shared__ __attribute__((aligned(16))) unsigned char lds[];
    Frame F;
    F.lds = (LAS unsigned char*)lds;
    F.MISC = (volatile LAS unsigned*)(F.lds + MISC_OFF);
    F.tid = threadIdx.x; F.lane = F.tid & 63; F.wave = __builtin_amdgcn_readfirstlane(F.tid >> 6);
    F.G = gridDim.x; { const int bx = blockIdx.x; F.vcu = (F.G % 8 == 0) ? (bx % 8) * (F.G / 8) + bx / 8 : bx; }
    unsigned char* ws = args.ws;
    F.ctl = (gu32*)(ws + WS_CTL);
    F.x = args.in[0]; F.c = args.in[1]; F.ctx = args.in[2]; F.c_ctx = args.in[3]; F.w_ada = args.in[4]; F.b_ada = args.in[5]; F.n1g = args.in[6]; F.n2g = args.in[7];
    F.w_in = args.in[8]; F.b_in = args.in[9]; F.sink = args.in[10]; F.w_pool = args.in[11]; F.pscale = args.in[12]; F.w_ab = args.in[13]; F.w_pb = args.in[14]; F.w_out = args.in[15];
    F.w_router = args.in[16]; F.b_router = args.in[17]; F.w_gu = args.in[18]; F.b_gu = args.in[19]; F.w_down = args.in[20]; F.b_down = args.in[21]; F.final_g = args.in[22];
    F.out = args.out; F.out2 = args.out; F.gcnt = F.ctl + CW_GCNT;
    F.modx = (float*)(ws + WS_MOD); F.modc = (float*)(ws + WS_MOD + 49152); F.ropec = (float*)(ws + WS_MOD + 65536); F.ropes = (float*)(ws + WS_MOD + 77824); F.GW = (float*)(ws + WS_GW);
    F.WpbT = (bf16*)(ws + WS_WPBT); F.Wp16 = (bf16*)(ws + WS_WP16); F.Win_t = (bf16*)(ws + WS_WIN); F.Wab_t = (bf16*)(ws + WS_WAB); F.Wpl_t = (bf16*)(ws + WS_WPL); F.Wout_t = (bf16*)(ws + WS_WOUT); F.Wgu8 = ws + WS_WGU; F.Wd8 = ws + WS_WD; F.H28 = ws + WS_H2; F.ACT8 = ws + WS_ACT; F.Win8 = ws + WS_WIN8; F.XN8 = ws + WS_XN8;
    F.XN = (bf16*)(ws + WS_XN); F.Q = (bf16*)(ws + WS_Q); F.KX = (bf16*)(ws + WS_KX); F.VX = (bf16*)(ws + WS_VX); F.U = (bf16*)(ws + WS_U); F.SA = (bf16*)(ws + WS_SA); F.SP = (bf16*)(ws + WS_SP);
    F.AO = (bf16*)(ws + WS_AO); F.DIFF = (bf16*)(ws + WS_DIFF); F.MRG = (bf16*)(ws + WS_MRG); F.Y2 = ws + WS_Y2;
    F.LIST = (int*)(ws + WS_LIST);
    if (args.probe && args.ph_lo == 6) { F.gcnt = F.ctl + 65536; F.LIST = (int*)(ws + WS_Q); F.GW = (float*)(ws + WS_Q + 4 * MiB); F.H28 = ws + WS_U; }
    if (args.probe && args.ph_lo == 9) { F.out2 = (float*)(ws + WS_Q); }
    for (int u = F.tid; u < (LDS_BYTES - LDSCTL_OFF) / 4; u += NWAVES * 64) ((LAS unsigned*)(F.lds + LDSCTL_OFF))[u] = 0u;
    __syncthreads();
    XcdBarrier bar; bar.bar = (unsigned*)(F.ctl + CW_BAR); bar.x = 0; bar.st = nullptr;
    if (N_LAUNCHES == 1) bar = xcd_barrier_post((unsigned*)(F.ctl + CW_BAR), F.MISC + 8);
#ifdef BAR_REP
#define GRID_BAR() do { if (N_LAUNCHES == 1) { xcd_barrier(bar); xcd_barrier(bar); } } while (0)
#else
#define GRID_BAR() do { if (N_LAUNCHES == 1) { xcd_barrier(bar); } } while (0)
#endif
    const int lo = args.ph_lo, hi = args.ph_hi;
#ifndef PH_MASK
#define PH_MASK 0x3ff
#endif
#define IN(k) (((PH_MASK >> (k)) & 1) && lo <= (k) && (k) < hi)
#define BOTH(k) (IN(k) && IN((k) + 1))
#ifndef REP_MASK
#define REP_MASK 0
#endif
#define REPS(k) for (int rep_ = 0; rep_ < 1 + ((REP_MASK >> (k)) & 1); ++rep_)
#ifdef TSA
#define TS_MARK(id) do { if ((id) == TSA && F.tid == 0) *(volatile LAS unsigned long long*)(F.lds + 146432) = __builtin_amdgcn_s_memrealtime(); if ((id) == TSB && F.tid == 0) *(volatile LAS unsigned long long*)(F.lds + 146440) = __builtin_amdgcn_s_memrealtime(); } while (0)
#else
#define TS_MARK(id) do {} while (0)
#endif
    TS_MARK(0);
    using namespace pg8;
    if (IN(0)) { REPS(0) p0_prologue(F); } TS_MARK(1);
    if (IN(1)) { REPS(1) p1_norm_mod(F, lo == 0); TS_MARK(2); if (BOTH(1)) GRID_BAR(); } TS_MARK(3);
    if (IN(2)) {
        constexpr int G8 = CVT_G8;
        OrdInProj8 S8{F.G == 256 ? G8 : F.G, (int)blockIdx.x, (const char*)F.XN8, (const char*)F.Win8};
        EpiInProj E8{F.b_in, F.Q, F.KX, F.U, (WS_VX - WS_KX) / 2, (WS_SA - WS_U) / 2, F.ropec, F.ropes, 1.0f / MOE_WSCALE};
        static_assert(WS_SP - WS_SA == WS_SA - WS_U, "U | SA | SP equally spaced");
        REPS(2) gemm_phase<EpiInProj, OrdInProj8, true, false, 1>(F.lds + RING_OFF, 1024, 1024, S8, E8);
        { OrdFold SF{F.G == 256 ? 240 : 0, (int)blockIdx.x, (const char*)F.WpbT, (const char*)F.Wp16}; EpiFold EF{(unsigned char*)F.Wpl_t};
          gemm_phase<EpiFold, OrdFold, true, false, 2>(F.lds + RING_OFF, 256, 256, SF, EF); }
        if (F.G == 256) { if ((int)blockIdx.x >= G8) convert_items(F, CVT_NITEMS - CVT_SLOT7 - CVT_SLOT2 + ((int)blockIdx.x - G8) * NWAVES + F.wave, CVT_NITEMS - CVT_SLOT7, (256 - G8) * NWAVES); }
        else convert_items(F, CVT_NITEMS - CVT_SLOT7 - CVT_SLOT2 + (int)blockIdx.x * NWAVES + F.wave, CVT_NITEMS - CVT_SLOT7, F.G * NWAVES);
        __syncthreads();
        TS_MARK(4);
        OrdInProjU SU{F.G, (int)blockIdx.x, (const char*)F.XN, (const char*)F.Win_t};
        EpiInProj EU{F.b_in, F.Q, F.KX, F.U, (WS_VX - WS_KX) / 2, (WS_SA - WS_U) / 2, F.ropec, F.ropes, 1.0f};
        REPS(2) gemm_phase<EpiInProj, OrdInProjU, true, false, 2>(F.lds + RING_OFF, 1024, 1024, SU, EU);
        TS_MARK(5);
        if (BOTH(2)) GRID_BAR();
    }
    TS_MARK(6);
    if (IN(3)) {
        const attn_body::AttnTensors AT{(const attn_body::bf16*)F.Q, (const attn_body::bf16*)F.KX, (const attn_body::bf16*)F.VX, (attn_body::bf16*)F.AO, F.sink};
        constexpr int G3 = CVT_G3; const int na = F.G == 256 ? G3 : F.G;
        const attn_body::StaticOrder S(na, (int)blockIdx.x);
        REPS(3) attn_body::attn_phase<attn_body::StaticOrder>((char*)lds + RING_OFF, AT, S);
        TS_MARK(7);
        if (CVT_SLOT3 > 0) {
            constexpr int s3 = CVT_NITEMS - CVT_SLOT7 - CVT_SLOT2 - CVT_SLOT3;
            if (F.G == 256 && G3 < 256) { if ((int)blockIdx.x >= G3) convert_items(F, s3 + ((int)blockIdx.x - G3) * NWAVES + F.wave, s3 + CVT_SLOT3, (256 - G3) * NWAVES); }
            else convert_items(F, s3 + (int)blockIdx.x * NWAVES + F.wave, s3 + CVT_SLOT3, F.G * NWAVES);
        }
        TS_MARK(8);
        REPS(10) p3_pool_diff(F);
        TS_MARK(9);
        if (BOTH(3)) GRID_BAR();
    }
    TS_MARK(10);
    if (IN(4)) {
        OrdMerge S{F.G, (int)blockIdx.x, (const char*)F.AO, (const char*)F.DIFF, (const char*)F.Wab_t, (const char*)F.Wpl_t};
        EpiMerge E{F.SA, F.SP, (unsigned char*)F.MRG};
        REPS(4) gemm_phase<EpiMerge, OrdMerge, true, false, 1>(F.lds + RING_OFF, 1024, 1024, S, E);
        TS_MARK(11);
        { Unit u0; if (BOTH(4) && N_LAUNCHES == 1 && S.next(0, u0)) panel_publish(F, 0, u0.pm); }
    }
    if (IN(5)) {
        OrdStatic S; S.init(M, D, F.G, (int)blockIdx.x, F.MRG, F.Wout_t, (size_t)256 * 1024);
        EpiOut E{F.modx, F.XN};
        { Unit u0; if (IN(4) && N_LAUNCHES == 1 && S.next(0, u0)) panel_wait(F, 0, u0.pm); }
        TS_MARK(12);
        REPS(5) gemm_phase<EpiOut, OrdStatic, false, false, 1>(F.lds + RING_OFF, 1024, 1024, S, E);
        TS_MARK(13);
        { Unit u0; if (BOTH(5) && N_LAUNCHES == 1 && S.next(0, u0)) panel_publish(F, 1, u0.pm); }
    }
    if (IN(6)) { p6_router(F, IN(5) && N_LAUNCHES == 1); TS_MARK(14); if (BOTH(6)) GRID_BAR(); } TS_MARK(15);
    if (IN(7)) {
        moe_prefix(F);
        volatile LAS int* PT = (volatile LAS int*)(F.lds + XTRA_OFF);
        const int U7 = (int)PT[32] * 8, rounds7 = (U7 + F.G - 1) / F.G, G7 = rounds7 > 0 ? (U7 + rounds7 - 1) / rounds7 : F.G, nsp = F.G - G7;
        OrdMoe S{G7, (int)blockIdx.x, 8, PT, PT + 64, (const char*)F.H28, (const char*)F.Wgu8, (size_t)2048 * 1024, (size_t)256 * 1024, F.LIST, 1};
        EpiSwiglu E{F.b_gu, F.ACT8};
        REPS(7) gemm_phase<EpiSwiglu, OrdMoe, true, true, 1>(F.lds + RING_OFF, 1024, 1024, S, E);
        TS_MARK(16);
        { constexpr int s0 = CVT_NITEMS - CVT_SLOT7; static_assert(CVT_SLOT7 <= 32 * 16 * 32, "the slot of the expert gate/up phase may only hold w_down items"); const int cap = nsp * NWAVES * CVT_CAP7 < CVT_SLOT7 ? nsp * NWAVES * CVT_CAP7 : CVT_SLOT7;
          if ((int)blockIdx.x >= G7) convert_items(F, s0 + ((int)blockIdx.x - G7) * NWAVES + F.wave, s0 + cap, nsp * NWAVES);
          if (cap < CVT_SLOT7) convert_items(F, s0 + cap + (int)blockIdx.x * NWAVES + F.wave, s0 + CVT_SLOT7, F.G * NWAVES); }
        TS_MARK(17);
        if (BOTH(7)) GRID_BAR();
    }
    TS_MARK(18);
    if (IN(8)) {
        moe_prefix(F);
        volatile LAS int* PT = (volatile LAS int*)(F.lds + XTRA_OFF);
        OrdMoe S{F.G, (int)blockIdx.x, 4, PT, PT + 64, (const char*)F.ACT8, (const char*)F.Wd8, (size_t)1024 * 1024, (size_t)256 * 1024, F.LIST, 0};
        EpiDown E{F.b_down, F.Y2, F.LIST, PT + 64};
        REPS(8) gemm_phase<EpiDown, OrdMoe, true, false, 1>(F.lds + RING_OFF, 1024, 1024, S, E);
        TS_MARK(19);
        if (BOTH(8)) GRID_BAR();
    }
    TS_MARK(20);
    if (IN(9)) { p9_final(F); }
    TS_MARK(21);
#ifdef TSA
#ifndef TSWHO
#define TSWHO -1
#endif
    if (F.tid == 0 && (TSWHO < 0 || (int)blockIdx.x == TSWHO)) { const unsigned long long ts_a = *(volatile LAS unsigned long long*)(F.lds + 146432), ts_b = *(volatile LAS unsigned long long*)(F.lds + 146440); const unsigned long long t_end = __builtin_amdgcn_s_memrealtime() + (unsigned long long)TSK * (ts_b - ts_a); while (__builtin_amdgcn_s_memrealtime() < t_end) __builtin_amdgcn_s_sleep(8); }
#endif
#undef IN
#undef BOTH
#undef GRID_BAR
}

extern "C" void kernel_launch(void* const* d_in, const int* in_sizes, int n_in, void* d_out, int out_size, void* d_ws, size_t ws_size, hipStream_t stream) {
    static int grid = 0;
    if (grid == 0) {
        if (n_in != 23 || in_sizes[0] != M * D || out_size != M * D || ws_size < WS_END) { fprintf(stderr, "kernel_launch: built for 23 inputs, x/out of %d floats, >= %zu bytes of workspace; got n_in %d, in0 %d, out %d, ws %zu; nothing launched\n", M * D, (size_t)WS_END, n_in, n_in > 0 ? in_sizes[0] : -1, out_size, ws_size); grid = -1; return; }
        int dev = 0, cus = 0, per_cu = 0;
        if (hipGetDevice(&dev) != hipSuccess || hipDeviceGetAttribute(&cus, hipDeviceAttributeMultiprocessorCount, dev) != hipSuccess) { fprintf(stderr, "kernel_launch: hipGetDevice / hipDeviceGetAttribute failed\n"); grid = -1; return; }
        if (hipFuncSetAttribute((const void*)fwd_megakernel, hipFuncAttributeMaxDynamicSharedMemorySize, LDS_BYTES) != hipSuccess) { fprintf(stderr, "kernel_launch: hipFuncSetAttribute failed\n"); grid = -1; return; }
        if (hipOccupancyMaxActiveBlocksPerMultiprocessor(&per_cu, (const void*)fwd_megakernel, NWAVES * 64, LDS_BYTES) != hipSuccess || per_cu < 1) { fprintf(stderr, "kernel_launch: occupancy query reports %d workgroups per CU; nothing launched\n", per_cu); (void)hipGetLastError(); grid = -1; return; }
        grid = cus;
        if (grid > 256) grid = 256;
    }
    if (grid < 0) return;
    if (hipMemsetAsync((char*)d_ws + WS_CTL, 0, CTL_ZERO_BYTES, stream) != hipSuccess) { fprintf(stderr, "kernel_launch: hipMemsetAsync failed\n"); return; }
#ifdef MEMSET_REP
    (void)hipMemsetAsync((char*)d_ws + WS_CTL, 0, CTL_ZERO_BYTES, stream);
#endif
    Args a{};
    for (int i = 0; i < 23; ++i) a.in[i] = (const float*)d_in[i];
    a.out = (float*)d_out; a.ws = (unsigned char*)d_ws;
    for (int li = 0; li < N_LAUNCHES; ++li) {
        a.ph_lo = (N_LAUNCHES == 1) ? 0 : li; a.ph_hi = (N_LAUNCHES == 1) ? N_PHASES : li + 1;
#ifdef PROBE_PHASE
        if (li == PROBE_PHASE) { a.probe = (li == 6 || li == 9) ? 1 : 0; hipLaunchKernelGGL(fwd_megakernel, dim3(grid), dim3(NWAVES * 64), LDS_BYTES, stream, a); a.probe = 0; }
#endif
        hipLaunchKernelGGL(fwd_megakernel, dim3(grid), dim3(NWAVES * 64), LDS_BYTES, stream, a);
        const hipError_t le = hipPeekAtLastError();
        if (le != hipSuccess) { fprintf(stderr, "kernel_launch: launch %d failed: %s\n", li, hipGetErrorName(le)); break; }
    }
}
```
